# Optimizing an MI355X kernel written in HIP

```python
import jax, jax.numpy as jnp
from jax import lax
import numpy as np


D_MODEL = 2048
BATCH = 4
SEQ = 8192
DEPTH = 2

CTX_LEN = 256
GRID_W = 64
CHUNK = 64
EPS = 1e-6
N_MOD = 6
CONV_W = 4

A_WIDTH = D_MODEL // 2
A_BLOCKS = 8
RG_C = 8.0
B_WIDTH = D_MODEL // 2
B_HEADS = 4
B_HD = B_WIDTH // B_HEADS
C_WIDTH = D_MODEL // 4
C_GROUP = 16
C_GROUPS = C_WIDTH // C_GROUP
C_STATE = 64
D_HEADS = 4
D_QK = D_MODEL // 4
D_V = D_MODEL // 2
D_DK = D_QK // D_HEADS
D_DV = D_V // D_HEADS
D_RANK = 16
D_TAU = 16.0

MIX0 = A_WIDTH + B_WIDTH
IN0 = 2 * A_WIDTH + 2 * B_WIDTH
MIX1 = C_WIDTH + D_V
IN1 = C_WIDTH + 2 * D_QK + 2 * D_V + 2 * D_RANK

FFN_DIM = 11 * D_MODEL // 4
N_EXPERTS = 8
TOP_K = 2
EXPERT_DIM = 11 * D_MODEL // 4

F32 = jnp.float32

kernel_name = 'hybrid_flow_backbone_block'


def _rmsnorm(x, g):
    xf = x.astype(F32)
    y = xf * lax.rsqrt(jnp.mean(xf * xf, axis=-1, keepdims=True) + EPS)
    return (y * g.astype(F32)).astype(x.dtype)


def _head_rmsnorm(x, g, n_heads):
    b, t, ch = x.shape
    xh = x.astype(F32).reshape(b, t, n_heads, ch // n_heads)
    xh = xh * lax.rsqrt(jnp.mean(xh * xh, axis=-1, keepdims=True) + EPS)
    return xh.reshape(b, t, ch) * g.astype(F32)


def _centred_dwconv(x, w, b):
    t = x.shape[1]
    left = CONV_W // 2
    xp = jnp.pad(x, ((0, 0), (left, CONV_W - 1 - left), (0, 0)))
    y = b
    for j in range(CONV_W):
        y = y + xp[:, j:j + t, :] * w[j]
    return y


def _block_diag(x, w):
    b, t, _ = x.shape
    nb, bi, bo = w.shape
    return jnp.einsum('btni,nio->btno', x.reshape(b, t, nb, bi), w).reshape(b, t, nb * bo)


def _split_heads(x, n_heads):
    b, t, ch = x.shape
    return x.reshape(b, t, n_heads, ch // n_heads).transpose(0, 2, 1, 3)


def _merge_heads(x):
    b, h, t, d = x.shape
    return x.transpose(0, 2, 1, 3).reshape(b, t, h * d)


def _to_chunks(x):
    b, h, t = x.shape[:3]
    return jnp.moveaxis(x.reshape((b, h, t // CHUNK, CHUNK) + x.shape[3:]), 2, 0)


def _from_chunks(x):
    x = jnp.moveaxis(x, 0, 2)
    return x.reshape(x.shape[:2] + (x.shape[2] * x.shape[3],) + x.shape[4:])


def _chunk_scan(step, state, seqs, reverse):
    if reverse:
        seqs = tuple(jnp.flip(s, axis=2) for s in seqs)
    state, out = lax.scan(step, state, tuple(_to_chunks(s) for s in seqs))
    out = _from_chunks(out)
    if reverse:
        out = jnp.flip(out, axis=2)
    return out, state


def _to_colmajor(h, rows):
    b, t, d = h.shape
    return h.reshape(b, rows, GRID_W, d).transpose(0, 2, 1, 3).reshape(b, t, d)


def _to_rowmajor(h, rows):
    b, t, d = h.shape
    return h.reshape(b, GRID_W, rows, d).transpose(0, 2, 1, 3).reshape(b, t, d)


def _linear_scan(a, b, h0, reverse):
    edge = -1 if reverse else 0
    b = b.at[:, edge].add(a[:, edge] * h0)

    def combine(e1, e2):
        a1, b1 = e1
        a2, b2 = e2
        return a1 * a2, a2 * b1 + b2

    _, h = lax.associative_scan(combine, (a, b), reverse=reverse, axis=1)
    return h


def _rglru(xc, wr, br, wi, bi, lam, h0, reverse):
    xf = xc.astype(F32)
    r = jax.nn.sigmoid((_block_diag(xc, wr) + br).astype(F32))
    i = jax.nn.sigmoid((_block_diag(xc, wi) + bi).astype(F32))
    log_a = -RG_C * r * jax.nn.softplus(-lam.astype(F32))
    a = jnp.exp(log_a)
    b = jnp.sqrt(-jnp.expm1(2.0 * log_a)) * (i * xf)
    return _linear_scan(a, b, h0, reverse)


def _mixer_rglru(xa_c, ga_c, xa_l, ga_l, p, ctx_out):
    xc_c = _centred_dwconv(xa_c, p['a_conv_w'], p['a_conv_b'])
    xc_l = _centred_dwconv(xa_l, p['a_conv_w'], p['a_conv_b'])
    h0 = jnp.zeros((xa_l.shape[0], A_WIDTH), F32)
    h_c, h_l = 0.0, 0.0
    for d, rev in enumerate((False, True)):
        dp = (p['a_wr'][d], p['a_br'][d], p['a_wi'][d], p['a_bi'][d], p['a_lam'][d])
        hc = _rglru(xc_c, *dp, h0, rev)
        h_last = hc[:, 0] if rev else hc[:, -1]
        h_l = h_l + _rglru(xc_l, *dp, h_last, rev)
        if ctx_out:
            h_c = h_c + hc
    y_l = (jax.nn.gelu(ga_l.astype(F32)) * h_l).astype(xa_l.dtype)
    y_c = (jax.nn.gelu(ga_c.astype(F32)) * h_c).astype(xa_c.dtype) if ctx_out else None
    return y_c, y_l


def _mlstm_chunk_step(carry, xs):
    c_st, n_st, m_st = carry
    q, k, v, li, lf = xs
    tri = jnp.tril(jnp.ones((CHUNK, CHUNK), dtype=bool))
    bcum = jnp.cumsum(lf, axis=-1)
    log_inter = bcum + m_st[..., None]
    log_intra = jnp.where(tri, bcum[..., :, None] - bcum[..., None, :] + li[..., None, :], -jnp.inf)
    m_t = jnp.maximum(log_inter, jnp.max(log_intra, axis=-1))
    w_inter = jnp.exp(log_inter - m_t)
    s = jnp.einsum('bhtd,bhsd->bhts', q, k) * jnp.exp(log_intra - m_t[..., None])
    num = jnp.einsum('bhts,bhsv->bhtv', s, v) + w_inter[..., None] * jnp.einsum('bhtk,bhkv->bhtv', q, c_st)
    den = jnp.sum(s, axis=-1) + w_inter * jnp.einsum('bhtk,bhk->bht', q, n_st)
    h = num / jnp.maximum(jnp.abs(den), jnp.exp(-m_t))[..., None]
    m_new = m_t[..., -1]
    w_state = jnp.exp(bcum[..., -1] + m_st - m_new)
    w_k = jnp.exp(bcum[..., -1:] - bcum + li - m_new[..., None])
    c_new = w_state[..., None, None] * c_st + jnp.einsum('bhs,bhsk,bhsv->bhkv', w_k, k, v)
    n_new = w_state[..., None] * n_st + jnp.einsum('bhs,bhsk->bhk', w_k, k)
    return (c_new, n_new, m_new), h


def _mixer_mlstm(xm_c, z_c, xm_l, z_l, p, ctx_out):
    def prep(xm):
        xc = jax.nn.silu(_centred_dwconv(xm, p['b_conv_w'], p['b_conv_b']))
        q = _split_heads(_block_diag(xc, p['b_wq']), B_HEADS).astype(F32) * (B_HD ** -0.5)
        k = _split_heads(_block_diag(xc, p['b_wk']), B_HEADS).astype(F32)
        v = _split_heads(_block_diag(xm, p['b_wv']), B_HEADS).astype(F32)
        return xc, q, k, v

    def gates(xc, d):
        g = (xc @ p['b_wif'][d] + p['b_bif'][d]).astype(F32).transpose(0, 2, 1)
        return g[:, :B_HEADS], jax.nn.log_sigmoid(g[:, B_HEADS:])

    xc_c, q_c, k_c, v_c = prep(xm_c)
    xc_l, q_l, k_l, v_l = prep(xm_l)
    bsz = xm_l.shape[0]
    st0 = (jnp.zeros((bsz, B_HEADS, B_HD, B_HD), F32), jnp.zeros((bsz, B_HEADS, B_HD), F32),
           jnp.zeros((bsz, B_HEADS), F32))
    h_c, h_l = 0.0, 0.0
    for d, rev in enumerate((False, True)):
        hc, st = _chunk_scan(_mlstm_chunk_step, st0, (q_c, k_c, v_c) + gates(xc_c, d), rev)
        hl, _ = _chunk_scan(_mlstm_chunk_step, st, (q_l, k_l, v_l) + gates(xc_l, d), rev)
        h_l = h_l + hl
        if ctx_out:
            h_c = h_c + hc

    def finish(h, z, xc):
        h = jax.nn.sigmoid(z.astype(F32)) * _merge_heads(h)
        return (_head_rmsnorm(h, p['b_norm'], B_HEADS) + p['b_skip'] * xc.astype(F32)).astype(z.dtype)

    y_l = finish(h_l, z_l, xc_l)
    y_c = finish(h_c, z_c, xc_c) if ctx_out else None
    return y_c, y_l


def _s5_discretize(lam_re, lam_im, log_dt, b_re, b_im):
    dt = jnp.exp(log_dt.astype(F32))[:, None]
    lr, lim = lam_re.astype(F32), lam_im.astype(F32)
    mag = jnp.exp(lr * dt)
    ab_re, ab_im = mag * jnp.cos(lim * dt), mag * jnp.sin(lim * dt)
    den = lr * lr + lim * lim
    nr, ni = ab_re - 1.0, ab_im
    co_re = (nr * lr + ni * lim) / den
    co_im = (ni * lr - nr * lim) / den
    br, bim = b_re.astype(F32), b_im.astype(F32)
    bb_re = co_re[..., None] * br - co_im[..., None] * bim
    bb_im = co_re[..., None] * bim + co_im[..., None] * br
    return ab_re, ab_im, bb_re, bb_im


def _complex_scan(ab_re, ab_im, bu_re, bu_im, s0_re, s0_im, reverse):
    edge = -1 if reverse else 0
    bu_re = bu_re.at[:, edge].add(ab_re * s0_re - ab_im * s0_im)
    bu_im = bu_im.at[:, edge].add(ab_re * s0_im + ab_im * s0_re)
    t = bu_re.shape[1]
    a_re = jnp.broadcast_to(ab_re, (1, t) + ab_re.shape)
    a_im = jnp.broadcast_to(ab_im, (1, t) + ab_im.shape)

    def combine(e1, e2):
        ar1, ai1, br1, bi1 = e1
        ar2, ai2, br2, bi2 = e2
        return (ar1 * ar2 - ai1 * ai2, ar1 * ai2 + ai1 * ar2,
                ar2 * br1 - ai2 * bi1 + br2, ar2 * bi1 + ai2 * br1 + bi2)

    _, _, s_re, s_im = lax.associative_scan(combine, (a_re, a_im, bu_re, bu_im), reverse=reverse, axis=1)
    return s_re, s_im


def _s5_readout(s_re, s_im, c_re, c_im):
    y = jnp.einsum('btgp,ghp->btgh', s_re, c_re.astype(F32)) - jnp.einsum('btgp,ghp->btgh', s_im, c_im.astype(F32))
    return y.reshape(y.shape[0], y.shape[1], C_WIDTH)


def _mixer_s5(u_c, u_l, p, ctx_out):
    def group(u):
        return u.astype(F32).reshape(u.shape[0], u.shape[1], C_GROUPS, C_GROUP)

    ug_c, ug_l = group(u_c), group(u_l)
    y_l = p['c_d'] * u_l.astype(F32)
    y_c = p['c_d'] * u_c.astype(F32) if ctx_out else None
    zeros = jnp.zeros((u_l.shape[0], C_GROUPS, C_STATE), F32)
    for d, rev in enumerate((False, True)):
        ab_re, ab_im, bb_re, bb_im = _s5_discretize(p['c_lam_re'][d], p['c_lam_im'][d], p['c_log_dt'][d],
                                                    p['c_b_re'], p['c_b_im'])
        bu_c = (jnp.einsum('btgh,gph->btgp', ug_c, bb_re), jnp.einsum('btgh,gph->btgp', ug_c, bb_im))
        bu_l = (jnp.einsum('btgh,gph->btgp', ug_l, bb_re), jnp.einsum('btgh,gph->btgp', ug_l, bb_im))
        sc_re, sc_im = _complex_scan(ab_re, ab_im, bu_c[0], bu_c[1], zeros, zeros, rev)
        e = 0 if rev else -1
        sl_re, sl_im = _complex_scan(ab_re, ab_im, bu_l[0], bu_l[1], sc_re[:, e], sc_im[:, e], rev)
        y_l = y_l + _s5_readout(sl_re, sl_im, p['c_c_re'][d], p['c_c_im'][d])
        if ctx_out:
            y_c = y_c + _s5_readout(sc_re, sc_im, p['c_c_re'][d], p['c_c_im'][d])

    def glu(y, dtype):
        return (y * jax.nn.sigmoid(jax.nn.gelu(y) @ p['c_glu_w'] + p['c_glu_b'])).astype(dtype)

    return (glu(y_c, u_c.dtype) if ctx_out else None), glu(y_l, u_l.dtype)


def _gla_chunk_step(s_st, xs):
    q, k, v, la = xs
    tri = jnp.tril(jnp.ones((CHUNK, CHUNK), dtype=bool))
    bcum = jnp.cumsum(la, axis=2)
    decay = jnp.exp(jnp.where(tri[:, :, None], bcum[:, :, :, None, :] - bcum[:, :, None, :, :], -jnp.inf))
    scores = jnp.einsum('bhtk,bhsk,bhtsk->bhts', q, k, decay)
    o = jnp.einsum('bhts,bhsv->bhtv', scores, v) + jnp.einsum('bhtk,bhkv->bhtv', q * jnp.exp(bcum), s_st)
    s_new = (jnp.exp(bcum[:, :, -1])[..., None] * s_st
             + jnp.einsum('bhsk,bhsv->bhkv', k * jnp.exp(bcum[:, :, -1:] - bcum), v))
    return s_new, o


def _mixer_gla(q_c, k_c, v_c, g_c, a_c, q_l, k_l, v_l, g_l, a_l, p, ctx_out):
    def prep(q, k, v):
        return (_split_heads(q, D_HEADS).astype(F32) * (D_DK ** -0.5),
                _split_heads(k, D_HEADS).astype(F32), _split_heads(v, D_HEADS).astype(F32))

    def log_decay(alr, d):
        z = alr[..., d * D_RANK:(d + 1) * D_RANK] @ p['d_wa2'][d] + p['d_ba2'][d]
        return _split_heads(jax.nn.log_sigmoid(z.astype(F32)) / D_TAU, D_HEADS)

    qkv_c, qkv_l = prep(q_c, k_c, v_c), prep(q_l, k_l, v_l)
    s0 = jnp.zeros((q_l.shape[0], D_HEADS, D_DK, D_DV), F32)
    o_c, o_l = 0.0, 0.0
    for d, rev in enumerate((False, True)):
        oc, st = _chunk_scan(_gla_chunk_step, s0, qkv_c + (log_decay(a_c, d),), rev)
        ol, _ = _chunk_scan(_gla_chunk_step, st, qkv_l + (log_decay(a_l, d),), rev)
        o_l = o_l + ol
        if ctx_out:
            o_c = o_c + oc

    def finish(o, g):
        return (_head_rmsnorm(_merge_heads(o), p['d_norm'], D_HEADS) * jax.nn.silu(g.astype(F32))).astype(g.dtype)

    return (finish(o_c, g_c) if ctx_out else None), finish(o_l, g_l)


def _even_mixer(h_c, h_l, p, ctx_out):
    cuts = [A_WIDTH, 2 * A_WIDTH, 2 * A_WIDTH + B_WIDTH]
    xa_c, ga_c, xb_c, zb_c = jnp.split(h_c @ p['w_in'], cuts, axis=-1)
    xa_l, ga_l, xb_l, zb_l = jnp.split(h_l @ p['w_in'], cuts, axis=-1)
    ya_c, ya_l = _mixer_rglru(xa_c, ga_c, xa_l, ga_l, p, ctx_out)
    yb_c, yb_l = _mixer_mlstm(xb_c, zb_c, xb_l, zb_l, p, ctx_out)
    y_l = jnp.concatenate([ya_l, yb_l], axis=-1) @ p['w_out']
    y_c = jnp.concatenate([ya_c, yb_c], axis=-1) @ p['w_out'] if ctx_out else None
    return y_c, y_l


def _odd_mixer(h_c, h_l, p, ctx_out):
    rows = h_l.shape[1] // GRID_W
    h_l = _to_colmajor(h_l, rows)
    cuts = [C_WIDTH, C_WIDTH + D_QK, C_WIDTH + 2 * D_QK, C_WIDTH + 2 * D_QK + D_V, C_WIDTH + 2 * D_QK + 2 * D_V]
    u_c, q_c, k_c, v_c, g_c, a_c = jnp.split(h_c @ p['w_in'], cuts, axis=-1)
    u_l, q_l, k_l, v_l, g_l, a_l = jnp.split(h_l @ p['w_in'], cuts, axis=-1)
    yc_c, yc_l = _mixer_s5(u_c, u_l, p, ctx_out)
    yd_c, yd_l = _mixer_gla(q_c, k_c, v_c, g_c, a_c, q_l, k_l, v_l, g_l, a_l, p, ctx_out)
    y_l = _to_rowmajor(jnp.concatenate([yc_l, yd_l], axis=-1) @ p['w_out'], rows)
    y_c = jnp.concatenate([yc_c, yd_c], axis=-1) @ p['w_out'] if ctx_out else None
    return y_c, y_l


def _swiglu(h, wi, wo):
    a, b = jnp.split(h @ wi, 2, axis=-1)
    return (jax.nn.silu(a) * b) @ wo


def _moe_swiglu(h, router, wi, wo):
    logits = (h @ router).astype(F32)
    top_v, top_i = lax.top_k(logits, TOP_K)
    top_w = jax.nn.softmax(top_v, axis=-1)
    gate = jnp.sum(jax.nn.one_hot(top_i, N_EXPERTS, dtype=F32) * top_w[..., None], axis=-2)
    out = 0.0
    for e in range(N_EXPERTS):
        out = out + gate[..., e:e + 1] * _swiglu(h, wi[e], wo[e])
    return out.astype(h.dtype)


def _layer(x_c, x_l, c_act, cc_act, p, even, ctx_out):
    sh1, sc1, g1, sh2, sc2, g2 = [m[:, None, :] for m in jnp.split(c_act @ p['mod_w'] + p['mod_b'], N_MOD, axis=-1)]
    csh1, csc1, cg1, csh2, csc2, cg2 = jnp.split(cc_act @ p['mod_w'] + p['mod_b'], N_MOD, axis=-1)
    h_l = _rmsnorm(x_l, p['norm1']) * (1.0 + sc1) + sh1
    h_c = _rmsnorm(x_c, p['norm1']) * (1.0 + csc1) + csh1
    y_c, y_l = (_even_mixer if even else _odd_mixer)(h_c, h_l, p, ctx_out)
    if even:
        ffn = lambda h: _swiglu(h, p['ffn_wi'], p['ffn_wo'])
    else:
        ffn = lambda h: _moe_swiglu(h, p['moe_router'], p['moe_wi'], p['moe_wo'])
    x_l = x_l + g1 * y_l
    x_l = x_l + g2 * ffn(_rmsnorm(x_l, p['norm2']) * (1.0 + sc2) + sh2)
    if ctx_out:
        x_c = x_c + cg1 * y_c
        x_c = x_c + cg2 * ffn(_rmsnorm(x_c, p['norm2']) * (1.0 + csc2) + csh2)
    return x_c, x_l


def setup_inputs(seed: int = 0) -> dict:
    key = jax.random.key(seed)
    ks = iter(jax.random.split(key, 96))
    D = D_MODEL

    def nrm(shape, scale):
        return scale * jax.random.normal(next(ks), shape, F32)

    def gain(n):
        return 1.0 + nrm((n,), 0.02)

    inp = {}
    inp['x'] = nrm((BATCH, SEQ, D), 1.0)
    inp['c'] = nrm((BATCH, D), 1.0)
    inp['ctx'] = nrm((BATCH, CTX_LEN, D), 1.0)
    inp['c_ctx'] = nrm((D,), 1.0)
    inp['l0_mod_w'] = nrm((D, N_MOD * D), 0.5 * D ** -0.5)
    inp['l0_mod_b'] = nrm((N_MOD * D,), 0.02)
    inp['l0_norm1'] = gain(D)
    inp['l0_norm2'] = gain(D)
    inp['l0_w_in'] = nrm((D, IN0), D ** -0.5)
    inp['l0_w_out'] = nrm((MIX0, D), MIX0 ** -0.5)
    blk = A_WIDTH // A_BLOCKS
    inp['l0_a_conv_w'] = nrm((CONV_W, A_WIDTH), CONV_W ** -0.5)
    inp['l0_a_conv_b'] = nrm((A_WIDTH,), 0.02)
    inp['l0_a_wr'] = nrm((2, A_BLOCKS, blk, blk), blk ** -0.5)
    inp['l0_a_br'] = nrm((2, A_WIDTH), 0.02)
    inp['l0_a_wi'] = nrm((2, A_BLOCKS, blk, blk), blk ** -0.5)
    inp['l0_a_bi'] = nrm((2, A_WIDTH), 0.02)
    a8 = jax.random.uniform(next(ks), (2, A_WIDTH), F32, minval=0.9, maxval=0.999)
    sa = a8 ** (1.0 / RG_C)
    inp['l0_a_lam'] = jnp.log(sa) - jnp.log1p(-sa)
    inp['l0_b_conv_w'] = nrm((CONV_W, B_WIDTH), CONV_W ** -0.5)
    inp['l0_b_conv_b'] = nrm((B_WIDTH,), 0.02)
    inp['l0_b_wq'] = nrm((B_HEADS, B_HD, B_HD), B_HD ** -0.5)
    inp['l0_b_wk'] = nrm((B_HEADS, B_HD, B_HD), B_HD ** -0.5)
    inp['l0_b_wv'] = nrm((B_HEADS, B_HD, B_HD), B_HD ** -0.5)
    inp['l0_b_wif'] = nrm((2, B_WIDTH, 2 * B_HEADS), B_WIDTH ** -0.5)
    f_bias = jnp.linspace(3.0, 6.0, B_HEADS, dtype=F32)[None, :] + nrm((2, B_HEADS), 0.1)
    inp['l0_b_bif'] = jnp.concatenate([nrm((2, B_HEADS), 0.1), f_bias], axis=-1)
    inp['l0_b_norm'] = gain(B_WIDTH)
    inp['l0_b_skip'] = gain(B_WIDTH)
    inp['l0_ffn_wi'] = nrm((D, 2 * FFN_DIM), D ** -0.5)
    inp['l0_ffn_wo'] = nrm((FFN_DIM, D), FFN_DIM ** -0.5)
    inp['l1_mod_w'] = nrm((D, N_MOD * D), 0.5 * D ** -0.5)
    inp['l1_mod_b'] = nrm((N_MOD * D,), 0.02)
    inp['l1_norm1'] = gain(D)
    inp['l1_norm2'] = gain(D)
    inp['l1_w_in'] = nrm((D, IN1), D ** -0.5)
    inp['l1_w_out'] = nrm((MIX1, D), MIX1 ** -0.5)
    inp['l1_c_lam_re'] = -0.5 * jnp.exp(nrm((2, C_GROUPS, C_STATE), 0.05))
    inp['l1_c_lam_im'] = jnp.pi * jnp.arange(C_STATE, dtype=F32)[None, None, :] + nrm((2, C_GROUPS, C_STATE), 0.05)
    inp['l1_c_log_dt'] = jax.random.uniform(next(ks), (2, C_GROUPS), F32, minval=float(np.log(0.001)), maxval=float(np.log(0.1)))
    inp['l1_c_b_re'] = nrm((C_GROUPS, C_STATE, C_GROUP), (2 * C_GROUP) ** -0.5)
    inp['l1_c_b_im'] = nrm((C_GROUPS, C_STATE, C_GROUP), (2 * C_GROUP) ** -0.5)
    inp['l1_c_c_re'] = nrm((2, C_GROUPS, C_GROUP, C_STATE), C_STATE ** -0.5)
    inp['l1_c_c_im'] = nrm((2, C_GROUPS, C_GROUP, C_STATE), C_STATE ** -0.5)
    inp['l1_c_d'] = nrm((C_WIDTH,), 1.0)
    inp['l1_c_glu_w'] = nrm((C_WIDTH, C_WIDTH), C_WIDTH ** -0.5)
    inp['l1_c_glu_b'] = nrm((C_WIDTH,), 0.02)
    inp['l1_d_wa2'] = nrm((2, D_RANK, D_QK), D_RANK ** -0.5)
    inp['l1_d_ba2'] = nrm((2, D_QK), 0.02)
    inp['l1_d_norm'] = gain(D_V)
    inp['l1_moe_router'] = nrm((D, N_EXPERTS), D ** -0.5)
    inp['l1_moe_wi'] = nrm((N_EXPERTS, D, 2 * EXPERT_DIM), D ** -0.5)
    inp['l1_moe_wo'] = nrm((N_EXPERTS, EXPERT_DIM, D), EXPERT_DIM ** -0.5)
    inp['final_norm'] = gain(D)
    return inp


def reference(x, c, ctx, c_ctx,
              l0_mod_w, l0_mod_b, l0_norm1, l0_norm2, l0_w_in, l0_w_out,
              l0_a_conv_w, l0_a_conv_b, l0_a_wr, l0_a_br, l0_a_wi, l0_a_bi, l0_a_lam,
              l0_b_conv_w, l0_b_conv_b, l0_b_wq, l0_b_wk, l0_b_wv, l0_b_wif, l0_b_bif, l0_b_norm, l0_b_skip,
              l0_ffn_wi, l0_ffn_wo,
              l1_mod_w, l1_mod_b, l1_norm1, l1_norm2, l1_w_in, l1_w_out,
              l1_c_lam_re, l1_c_lam_im, l1_c_log_dt, l1_c_b_re, l1_c_b_im, l1_c_c_re, l1_c_c_im,
              l1_c_d, l1_c_glu_w, l1_c_glu_b,
              l1_d_wa2, l1_d_ba2, l1_d_norm,
              l1_moe_router, l1_moe_wi, l1_moe_wo,
              final_norm):
    layers = [
        dict(mod_w=l0_mod_w, mod_b=l0_mod_b, norm1=l0_norm1, norm2=l0_norm2, w_in=l0_w_in, w_out=l0_w_out,
             a_conv_w=l0_a_conv_w, a_conv_b=l0_a_conv_b, a_wr=l0_a_wr, a_br=l0_a_br, a_wi=l0_a_wi,
             a_bi=l0_a_bi, a_lam=l0_a_lam,
             b_conv_w=l0_b_conv_w, b_conv_b=l0_b_conv_b, b_wq=l0_b_wq, b_wk=l0_b_wk, b_wv=l0_b_wv,
             b_wif=l0_b_wif, b_bif=l0_b_bif, b_norm=l0_b_norm, b_skip=l0_b_skip,
             ffn_wi=l0_ffn_wi, ffn_wo=l0_ffn_wo),
        dict(mod_w=l1_mod_w, mod_b=l1_mod_b, norm1=l1_norm1, norm2=l1_norm2, w_in=l1_w_in, w_out=l1_w_out,
             c_lam_re=l1_c_lam_re, c_lam_im=l1_c_lam_im, c_log_dt=l1_c_log_dt, c_b_re=l1_c_b_re,
             c_b_im=l1_c_b_im, c_c_re=l1_c_c_re, c_c_im=l1_c_c_im, c_d=l1_c_d, c_glu_w=l1_c_glu_w,
             c_glu_b=l1_c_glu_b, d_wa2=l1_d_wa2, d_ba2=l1_d_ba2, d_norm=l1_d_norm,
             moe_router=l1_moe_router, moe_wi=l1_moe_wi, moe_wo=l1_moe_wo),
    ]
    c_act = jax.nn.silu(c)
    cc_act = jax.nn.silu(c_ctx)
    x_c, x_l = ctx, x
    for l in range(DEPTH):
        x_c, x_l = _layer(x_c, x_l, c_act, cc_act, layers[l], l % 2 == 0, l < DEPTH - 1)
    return _rmsnorm(x_l, final_norm)
```

```cpp
#include <hip/hip_runtime.h>
#include <cstdio>
#include <cstdint>

#ifndef MK_PER_PHASE
#define MK_PER_PHASE 0
#endif

#ifndef FP8_MOE
#define FP8_MOE 1
#endif
#ifndef FP8_FFN
#define FP8_FFN 1
#endif
#ifndef FP8_SP2
#define FP8_SP2 true
#endif
#define DI __device__ __forceinline__
#define LAS __attribute__((address_space(3)))
typedef unsigned short bf16_t;
typedef float f32x4 __attribute__((ext_vector_type(4)));
typedef float f32x2 __attribute__((ext_vector_type(2)));
typedef unsigned u32x4 __attribute__((ext_vector_type(4)));
typedef unsigned u32x2 __attribute__((ext_vector_type(2)));
typedef short bf16x8 __attribute__((ext_vector_type(8)));

constexpr int D = 2048, NB = 4, T = 8192, TC = 256;
constexpr int NL = NB * T;
constexpr int NCX = NB * TC;
constexpr int NT = NL + NCX;
constexpr int FF = 5632, FF2 = 11264;
constexpr int IN0 = 4096, IN1 = 3616, IN1P = 3840, MIX1 = 1536;
constexpr int NEXP = 8;
constexpr int MOE_ROWS = 2 * NL + NEXP * 256;
constexpr float EPS = 1e-6f;
constexpr int NSTEP = TC + T;

enum { I_X = 0, I_C, I_CTX, I_CCTX,
       I0_MODW, I0_MODB, I0_N1, I0_N2, I0_WIN, I0_WOUT, I0_ACW, I0_ACB, I0_AWR, I0_ABR, I0_AWI, I0_ABI, I0_ALAM,
       I0_BCW, I0_BCB, I0_BWQ, I0_BWK, I0_BWV, I0_BWIF, I0_BBIF, I0_BNORM, I0_BSKIP, I0_FWI, I0_FWO,
       I1_MODW, I1_MODB, I1_N1, I1_N2, I1_WIN, I1_WOUT, I1_LRE, I1_LIM, I1_LDT, I1_BRE, I1_BIM, I1_CRE, I1_CIM, I1_CD, I1_GLUW, I1_GLUB,
       I1_WA2, I1_BA2, I1_DNORM, I1_ROUTER, I1_MWI, I1_MWO, I_FNORM, N_IN };

constexpr size_t MiB = 1u << 20;
constexpr size_t WS_CTL = 0, CTL_BYTES = 1 * MiB;
constexpr size_t WS_MOD = 1 * MiB;
constexpr size_t WS_S5AB = 2 * MiB;
constexpr size_t WS_S5BB = 2 * MiB + 256 * 1024;
constexpr size_t WS_GATES = 3 * MiB;
constexpr size_t WS_ROUTE = 6 * MiB;
constexpr size_t RT_TOPE = WS_ROUTE, RT_TOPW = WS_ROUTE + 256 * 1024, RT_POS = WS_ROUTE + 512 * 1024, RT_CNT = WS_ROUTE + 768 * 1024, RT_TEXP = RT_CNT + 8192, RT_NTILES = RT_TEXP + 2048;
constexpr size_t WS_XCX = 8 * MiB;
constexpr size_t WS_WT = 16 * MiB;
constexpr size_t WT_IN0 = WS_WT, WT_OUT0 = WT_IN0 + 16 * MiB, WT_FWI0 = WT_OUT0 + 8 * MiB, WT_FWO0 = WT_FWI0 + 44 * MiB,
                 WT_IN1 = WT_FWO0 + 22 * MiB, WT_OUT1 = WT_IN1 + 15 * MiB, WT_MWI = WT_OUT1 + 6 * MiB, WT_MWO = WT_MWI + 352 * MiB,
                 WT_GLU = WT_MWO + 176 * MiB, WT_RG = WT_GLU + 1 * MiB, WT_QK = WT_RG + 1 * MiB, WT_V = WT_QK + 1 * MiB, WT_GT = WT_V + 1 * MiB,
                 WT_S5W1 = WT_GT + 1 * MiB,
                 WT_S5W3 = WT_S5W1 + 12 * MiB,
                 WS_ACTS = WT_S5W3 + 4 * MiB;
constexpr size_t R_H = WS_ACTS;
constexpr size_t R_F = R_H + 132 * MiB;
constexpr size_t R_B = R_F + 132 * MiB;
constexpr size_t R_C = R_B + 264 * MiB;
constexpr size_t R_D = R_C + 396 * MiB;
constexpr size_t R_E = R_D + 198 * MiB;
constexpr size_t A_ST = R_E + 264 * MiB;
constexpr size_t A_GAM = A_ST + 562 * MiB;
constexpr size_t A_SEG = A_GAM + 3 * MiB;
constexpr size_t WS_SSQ = A_SEG + 2 * MiB;
constexpr size_t WS_BIAS2 = WS_SSQ + 5 * MiB;
constexpr size_t WS_BIAS1 = WS_BIAS2 + 512 * 1024;
constexpr size_t WS_BIASP = WS_SSQ + 6 * MiB;
constexpr size_t WS_END = WS_SSQ + 9 * MiB;
constexpr size_t A_H = R_H, A_Y = R_F, A_PROJ = R_B, A_HS = R_B;
constexpr size_t A_XCA = R_C, A_XCB = R_C + 66 * MiB, A_RG = R_C + 132 * MiB, A_IX = R_C + 264 * MiB;
constexpr size_t A_Q0 = R_D, A_K0 = R_D + 66 * MiB, A_V0 = R_D + 132 * MiB;
constexpr size_t A_HA = R_E, A_HB = R_E + 132 * MiB;
constexpr size_t A_ACT0 = R_B;
constexpr size_t A_YS = R_C;
constexpr size_t A_GY = R_D, A_YSUM = R_D + 32 * MiB;
constexpr size_t A_O = R_E;
constexpr int S5ROWS = 2304;
constexpr size_t A_YI = R_H;
constexpr size_t A_SIN = R_H + 72 * MiB;
constexpr size_t A_SLOC = R_F;
constexpr size_t A_ACT1 = R_C;
constexpr size_t A_YM = R_H;
static_assert((size_t)MOE_ROWS * FF * 2 <= (396 + 198 + 264) * MiB, "ACT1 fits");
static_assert((size_t)MOE_ROWS * D * 2 <= 264 * MiB, "YM/HS fit");
static_assert((size_t)NT * FF * 2 <= (264 + 132) * MiB, "ACT0 fits in R_B + XCA|XCB");

constexpr int RING_BYTES = 131072;
constexpr int MISC_OFF = RING_BYTES;
constexpr int LDS_BYTES = 147456;

DI float bf2f(unsigned v) { return __uint_as_float(v << 16); }
typedef __bf16 bf16x2_native __attribute__((ext_vector_type(2)));
DI unsigned cvt_pk_bf16(float lo, float hi) { bf16x2_native v = {(__bf16)lo, (__bf16)hi}; return __builtin_bit_cast(unsigned, v); }
DI unsigned short f2bf(float f) { return (unsigned short)(cvt_pk_bf16(f, 0.f) & 0xffffu); }
constexpr float S8_H = 16.f, S8_W1 = 512.f, S8_ACT = 8.f, S8_W2 = 1024.f;
DI float clamp8(float v) { return fminf(fmaxf(v, -448.f), 448.f); }
DI unsigned pack4_fp8(float a, float b, float c, float d) { unsigned w = 0; w = __builtin_amdgcn_cvt_pk_fp8_f32(clamp8(a), clamp8(b), w, false); w = __builtin_amdgcn_cvt_pk_fp8_f32(clamp8(c), clamp8(d), w, true); return w; }
template <int CTRL, int RMASK, bool BC> DI float dpp_mov(float src) { return __int_as_float(__builtin_amdgcn_update_dpp(0, __float_as_int(src), CTRL, RMASK, 0xf, BC)); }
DI float wave_scan(float v, int = 0) {
    v += dpp_mov<0x111, 0xf, true>(v);
    v += dpp_mov<0x112, 0xf, true>(v);
    v += dpp_mov<0x114, 0xf, true>(v);
    v += dpp_mov<0x118, 0xf, true>(v);
    v += dpp_mov<0x142, 0xa, false>(v);
    v += dpp_mov<0x143, 0xc, false>(v);
    return v;
}
DI float wave_sum(float v) { return __int_as_float(__builtin_amdgcn_readlane(__float_as_int(wave_scan(v)), 63)); }
DI float sigmoidf_(float x) { return __builtin_amdgcn_rcpf(1.f + __expf(-x)); }
DI float siluf_(float x) { return x * __builtin_amdgcn_rcpf(1.f + __expf(-x)); }
DI float gelu_tanh(float x) { const float u = 0.7978845608028654f * (x + 0.044715f * x * x * x); const float e = __expf(2.f * u); const float th = 1.f - 2.f * __builtin_amdgcn_rcpf(e + 1.f); return 0.5f * x * (1.f + th); }
DI float log_sigmoidf_(float x) { return fminf(x, 0.f) - __logf(1.f + __expf(-fabsf(x))); }
DI void unpack8(const u32x4 w, float (&f)[8]) {
    f[0] = bf2f(w.x & 0xffffu); f[1] = bf2f(w.x >> 16); f[2] = bf2f(w.y & 0xffffu); f[3] = bf2f(w.y >> 16);
    f[4] = bf2f(w.z & 0xffffu); f[5] = bf2f(w.z >> 16); f[6] = bf2f(w.w & 0xffffu); f[7] = bf2f(w.w >> 16);
}
DI u32x4 pack8(const float (&f)[8]) { u32x4 w; w.x = cvt_pk_bf16(f[0], f[1]); w.y = cvt_pk_bf16(f[2], f[3]); w.z = cvt_pk_bf16(f[4], f[5]); w.w = cvt_pk_bf16(f[6], f[7]); return w; }
DI int chain_row(int d, int b, int j) {
    if (j < TC) { const int t = d ? (TC - 1 - j) : j; return NL + b * TC + t; }
    const int jj = j - TC; const int t = d ? (T - 1 - jj) : jj; return b * T + t;
}

namespace pg8 {
constexpr int BM = 256, BK = 64, HALF = 128, HTB = HALF * BK * 2, STAGE_BYTES = 8 * HTB, NXCD = 8, WGM = 8;
__host__ __device__ __forceinline__ int lds_byte(int r, int c) { const int st = (r >> 4) * 2 + (c >> 5), rr = r & 15, cc = c & 31, ob = rr * 64 + cc * 2; return st * 1024 + (ob ^ (((ob >> 9) & 1) << 5)); }
__host__ __device__ __forceinline__ void stage_rc(int b, int& R, int& C) { const int st = b / 1024, sb = b % 1024, swz = sb ^ (((sb >> 9) & 1) << 5); R = (st >> 1) * 16 + swz / 64; C = (st & 1) * 32 + (swz % 64) / 2; }
__host__ __device__ __forceinline__ int perm32(int rho) { const int n = rho >> 4, i = rho & 15; return 8 * (i >> 2) + 4 * n + (i & 3); }

struct Unit { int pm, pn; long aoff, boff; int par; };
struct Gemm { const bf16_t* A; const bf16_t* Bt; int lda, ldb, K; int amode; };

struct Sched {
    int nM, nN, G, c;
    long a_tile, b_tile;
    int ppb; long a_blk;
    const int* texp; int e_tiles;
    DI bool next(int i, Unit& u) const {
        const long L = (long)i * G + c; const int nwg = nM * nN; if (L >= nwg) return false;
        int wgid = (int)L; { const int q = nwg / NXCD, r = nwg % NXCD, xcd = wgid % NXCD, off = wgid / NXCD; wgid = (xcd < r ? xcd * (q + 1) : r * (q + 1) + (xcd - r) * q) + off; }
        const int nig = WGM * nN, gid = wgid / nig, fm = gid * WGM, gsz = (nM - fm) < WGM ? (nM - fm) : WGM;
        u.pm = fm + ((wgid % nig) % gsz); u.pn = (wgid % nig) / gsz;
        u.aoff = (long)u.pm * a_tile + (long)(u.pn / ppb) * a_blk;
        const int bt = texp ? (texp[u.pm] * e_tiles + u.pn) : u.pn;
        u.boff = (long)bt * b_tile;
        return true;
    }
    DI void a_ready(const Unit&) const {}
    DI void done(const Unit&) const {}
};
DI Sched make_sched(int nM, int nN, int G, int c, int lda, int ldb) { Sched s; s.nM = nM; s.nN = nN; s.G = G; s.c = c; s.a_tile = (long)256 * lda * 2; s.b_tile = (long)256 * ldb * 2; s.ppb = 1 << 30; s.a_blk = 0; s.texp = nullptr; s.e_tiles = 0; return s; }

template <class T, class = void> struct has_prefetch { static constexpr bool value = false; };
template <class T> struct has_prefetch<T, decltype(void(&T::prefetch))> { static constexpr bool value = true; };
typedef f32x4 Acc[2][2][4][2];

DI void store_tile_bf16(const Acc& acc, bf16_t* O, long ldc, long row_base, int col_base, float sc, int wr, int wc, int fr, int fq) {
#pragma unroll
    for (int ai = 0; ai < 2; ++ai)
#pragma unroll
        for (int m = 0; m < 4; ++m) {
            bf16_t* rowp = O + (row_base + ai * HALF + wr * 64 + m * 16 + fr) * ldc + col_base + wc * 32 + 8 * fq;
#pragma unroll
            for (int bj = 0; bj < 2; ++bj) {
                const f32x4 v0 = acc[ai][bj][m][0] * sc, v1 = acc[ai][bj][m][1] * sc;
                u32x4 w; w.x = cvt_pk_bf16(v0[0], v0[1]); w.y = cvt_pk_bf16(v0[2], v0[3]); w.z = cvt_pk_bf16(v1[0], v1[1]); w.w = cvt_pk_bf16(v1[2], v1[3]);
                *(u32x4*)(rowp + bj * HALF) = w;
            }
        }
}
struct EpiBf16 {
    static constexpr bool PERM = true, AFTER_DRAIN = false;
    bf16_t* O; int ldc; float sc;
    DI void operator()(const Acc& acc, const Unit& u, int wr, int wc, int fr, int fq) const { store_tile_bf16(acc, O, ldc, (long)u.pm * BM, u.pn * BM, sc, wr, wc, fr, fq); }
};
constexpr int RSTD_OFF = RING_BYTES + 4096;
DI void rows_rstd(const float* ssq, LAS float* rsl, int pm, int& cur_pm, int wr, int wc, int fr, int fq, float (&rs)[2][4]) {
    if (pm != cur_pm) {
        cur_pm = pm;
        const int t = (wr * 4 + wc) * 64 + fq * 16 + fr;
        const f32x4* pp = (const f32x4*)(ssq + ((long)pm * BM + (t >> 1)) * 32 + 16 * (t & 1));
        const f32x4 a = pp[0], b = pp[1], c = pp[2], d = pp[3];
        float s = (((a[0] + a[1]) + (a[2] + a[3])) + ((b[0] + b[1]) + (b[2] + b[3]))) + (((c[0] + c[1]) + (c[2] + c[3])) + ((d[0] + d[1]) + (d[2] + d[3])));
        const float o = __shfl_xor(s, 1);
        if (!(t & 1)) rsl[t >> 1] = rsqrtf((s + o) * (1.f / D) + EPS);
        asm volatile("s_waitcnt lgkmcnt(0)" ::: "memory"); __builtin_amdgcn_s_barrier();
    }
#pragma unroll
    for (int ai = 0; ai < 2; ++ai)
#pragma unroll
        for (int m = 0; m < 4; ++m) rs[ai][m] = rsl[ai * HALF + wr * 64 + m * 16 + fr];
}
struct EpiBf16N {
    static constexpr bool PERM = true, AFTER_DRAIN = false;
    bf16_t* O; int ldc; const float* ssq; const float* bias; int ldbias; mutable int cur_pm; LAS float* rsl;
    DI void prefetch(const Unit& u, int wid, int lane) const {
        if (wid != 0) return;
        const long rb = (long)u.pm * BM; const int bidx = rb < NL ? (int)(rb >> 13) : 4;
        __builtin_amdgcn_global_load_lds((const unsigned*)(bias + bidx * ldbias + u.pn * BM + lane * 4), (LAS unsigned*)(rsl + 256 + u.par * 256), 16, 0, 0);
    }
    DI void operator()(const Acc& acc, const Unit& u, int wr, int wc, int fr, int fq) const {
        asm volatile("" : "+v"(fr), "+v"(fq));
        const long rb = (long)u.pm * BM;
        float rs[2][4]; rows_rstd(ssq, rsl, u.pm, cur_pm, wr, wc, fr, fq, rs);
        const LAS float* bp = rsl + 256 + u.par * 256 + wc * 32 + 8 * fq;
        f32x4 bv[2][2];
#pragma unroll
        for (int bj = 0; bj < 2; ++bj) { bv[bj][0] = *(const LAS f32x4*)(bp + bj * HALF); bv[bj][1] = *(const LAS f32x4*)(bp + bj * HALF + 4); }
#pragma unroll
        for (int ai = 0; ai < 2; ++ai)
#pragma unroll
            for (int m = 0; m < 4; ++m) {
                bf16_t* rowp = O + (rb + ai * HALF + wr * 64 + m * 16 + fr) * ldc + u.pn * BM + wc * 32 + 8 * fq;
                const float r = rs[ai][m];
#pragma unroll
                for (int bj = 0; bj < 2; ++bj) {
                    const f32x4 v0 = acc[ai][bj][m][0] * r + bv[bj][0], v1 = acc[ai][bj][m][1] * r + bv[bj][1];
                    u32x4 w; w.x = cvt_pk_bf16(v0[0], v0[1]); w.y = cvt_pk_bf16(v0[2], v0[3]); w.z = cvt_pk_bf16(v1[0], v1[1]); w.w = cvt_pk_bf16(v1[2], v1[3]);
                    *(u32x4*)(rowp + bj * HALF) = w;
                }
            }
    }
};
struct EpiQK {
    static constexpr bool PERM = true, AFTER_DRAIN = false;
    bf16_t* Q; bf16_t* Kk; float qscale;
    DI void operator()(const Acc& acc, const Unit& u, int wr, int wc, int fr, int fq) const {
        const int h = u.pn >> 1, j = u.pn & 1;
        store_tile_bf16(acc, j ? Kk : Q, 1024, (long)u.pm * BM, h * 256, j ? 1.f : qscale, wr, wc, fr, fq);
    }
};
struct EpiRG {
    static constexpr bool PERM = true, AFTER_DRAIN = false;
    const bf16_t* XCA; bf16_t* RG; bf16_t* IX; const float* br; const float* bi;
    DI void operator()(const Acc& acc, const Unit& u, int wr, int wc, int fr, int fq) const {
        const int blk = u.pn >> 1, d = u.pn & 1;
        const int ch0 = blk * 128 + wc * 32 + 8 * fq;
        const float* brp = br + d * 1024 + ch0; const float* bip = bi + d * 1024 + ch0;
        u32x4 xwv[2][4];
#pragma unroll
        for (int ai = 0; ai < 2; ++ai)
#pragma unroll
            for (int m = 0; m < 4; ++m) xwv[ai][m] = *(const u32x4*)(XCA + ((long)u.pm * BM + ai * HALF + wr * 64 + m * 16 + fr) * 1024 + ch0);
        f32x4 b_rv[2], b_iv[2];
#pragma unroll
        for (int n = 0; n < 2; ++n) { b_rv[n] = *(const f32x4*)(brp + 4 * n); b_iv[n] = *(const f32x4*)(bip + 4 * n); }
#pragma unroll
        for (int ai = 0; ai < 2; ++ai)
#pragma unroll
            for (int m = 0; m < 4; ++m) {
                const long row = (long)u.pm * BM + ai * HALF + wr * 64 + m * 16 + fr;
                const u32x4 xw = xwv[ai][m];
                const unsigned xws[4] = {xw.x, xw.y, xw.z, xw.w};
                unsigned ro[4], io[4];
#pragma unroll
                for (int n = 0; n < 2; ++n) {
                    const f32x4 b_r = b_rv[n], b_i = b_iv[n];
                    float r[4], ig[4];
#pragma unroll
                    for (int q = 0; q < 4; ++q) { r[q] = sigmoidf_(acc[ai][0][m][n][q] + b_r[q]); ig[q] = sigmoidf_(acc[ai][1][m][n][q] + b_i[q]); }
                    const float x0 = bf2f(xws[2 * n] & 0xffffu), x1 = bf2f(xws[2 * n] >> 16), x2 = bf2f(xws[2 * n + 1] & 0xffffu), x3 = bf2f(xws[2 * n + 1] >> 16);
                    ro[2 * n] = cvt_pk_bf16(r[0], r[1]); ro[2 * n + 1] = cvt_pk_bf16(r[2], r[3]);
                    io[2 * n] = cvt_pk_bf16(ig[0] * x0, ig[1] * x1); io[2 * n + 1] = cvt_pk_bf16(ig[2] * x2, ig[3] * x3);
                }
                *(u32x4*)(RG + ((long)d * NT + row) * 1024 + ch0) = (u32x4){ro[0], ro[1], ro[2], ro[3]};
                *(u32x4*)(IX + ((long)d * NT + row) * 1024 + ch0) = (u32x4){io[0], io[1], io[2], io[3]};
                asm volatile("" ::: "memory");
            }
    }
};
struct EpiGates {
    static constexpr bool PERM = false, AFTER_DRAIN = false;
    float* GT; const float* bif;
    DI void operator()(const Acc& acc, const Unit& u, int wr, int wc, int fr, int fq) const {
        if (wc != 0) return;
        const f32x4 bv = *(const f32x4*)(bif + 4 * fq);
#pragma unroll
        for (int ai = 0; ai < 2; ++ai)
#pragma unroll
            for (int m = 0; m < 4; ++m) {
                const long row = (long)u.pm * BM + ai * HALF + wr * 64 + m * 16 + fr;
                *(f32x4*)(GT + row * 16 + 4 * fq) = acc[ai][0][m][0] + bv;
            }
    }
};
#ifndef EPI_PD
#define EPI_PD 3
#endif
template <int AOUT> struct EpiResidT {
    static constexpr bool PERM = true, AFTER_DRAIN = false;
    const float* srcLi; const float* srcCi; const float* gam; unsigned char* ws; float* out;
    int layer, goff, perm; float sc;
    int nlayer, scoff, aperm;
    DI void operator()(const Acc& acc, const Unit& u, int wr, int wc, int fr, int fq) const {
        if constexpr (AOUT != 0) asm volatile("" : "+v"(fr), "+v"(fq));
        unsigned long pw = (unsigned long)ws, po = (unsigned long)out;
        unsigned pwl = __builtin_amdgcn_readfirstlane((unsigned)pw), pwh = __builtin_amdgcn_readfirstlane((unsigned)(pw >> 32)), pol = __builtin_amdgcn_readfirstlane((unsigned)po), poh = __builtin_amdgcn_readfirstlane((unsigned)(po >> 32));
        asm volatile("" : "+s"(pwl), "+s"(pwh), "+s"(pol), "+s"(poh));
        unsigned char* wsp = (unsigned char*)(((unsigned long)pwh << 32) | pwl); float* outp = (float*)(((unsigned long)poh << 32) | pol);
        float* const XCXp = (float*)(wsp + WS_XCX);
        const float* srcL = srcLi ? srcLi : outp; const float* srcC = srcCi ? srcCi : XCXp; float* dstL = outp; float* dstC = XCXp;
        const float* mod = (const float*)(wsp + WS_MOD) + layer * 5 * 12288; const float* nmod = (const float*)(wsp + WS_MOD) + nlayer * 5 * 12288;
        void* A = wsp + A_H; float* ssq = (float*)(wsp + WS_SSQ);
        const long rb = (long)u.pm * BM;
        const int bidx = rb < NL ? (int)(rb >> 13) : 4;
        const float* gate = mod + bidx * 12288 + goff;
        const int col0 = u.pn * BM + wc * 32 + 8 * fq;
        constexpr int PD = EPI_PD;
        const bool lat = rb < NL;
        const float* const sB = lat ? srcL : srcC; float* const dB = lat ? dstL : dstC;
        const int r0 = (int)(lat ? rb : rb - NL) + wr * 64 + fr;
        const int a0row = (int)rb + wr * 64 + fr;
        float ssr[8];
#pragma unroll
        for (int bj = 0; bj < 2; ++bj) {
            const int c = col0 + bj * HALF;
            f32x4 gv[2], gm[2];
#pragma unroll
            for (int n = 0; n < 2; ++n) {
                gv[n] = *(const f32x4*)(gate + c + n * 4) * sc;
                if constexpr (AOUT != 0) gm[n] = *(const f32x4*)(gam + c + n * 4) * (*(const f32x4*)(nmod + bidx * 12288 + scoff + c + n * 4) + 1.f) * (AOUT == 1 ? S8_H : 1.f);
            }
            f32x4 sv[PD][2];
#pragma unroll
            for (int it = 0; it < 8 + PD; ++it) {
                if (it >= PD) {
                    const int ir = it - PD, ai = ir >> 2, m = ir & 3;
                    int lr = r0 + ai * HALF + m * 16;
                    if (perm && lat) { const int tp = lr & 8191, j = tp >> 7, i = tp & 127; lr = (lr & ~8191) + i * 64 + j; }
                    const unsigned off = (unsigned)lr * D + c;
                    const f32x4 x0 = sv[ir % PD][0] + gv[0] * acc[ai][bj][m][0], x1 = sv[ir % PD][1] + gv[1] * acc[ai][bj][m][1];
                    *(f32x4*)(dB + off) = x0; *(f32x4*)(dB + off + 4) = x1;
                    if constexpr (AOUT != 0) {
                        int arow = a0row + ai * HALF + m * 16;
                        if (aperm && lat) { const int t = arow & 8191, i = t >> 6, j = t & 63; arow = (arow & ~8191) + j * 128 + i; }
                        const unsigned aoff = (unsigned)arow * D + c;
                        const float sq = ((x0[0] * x0[0] + x0[1] * x0[1]) + (x0[2] * x0[2] + x0[3] * x0[3])) + ((x1[0] * x1[0] + x1[1] * x1[1]) + (x1[2] * x1[2] + x1[3] * x1[3]));
                        const f32x4 a0 = x0 * gm[0], a1 = x1 * gm[1];
                        if constexpr (AOUT == 1) { u32x2 w; w.x = pack4_fp8(a0[0], a0[1], a0[2], a0[3]); w.y = pack4_fp8(a1[0], a1[1], a1[2], a1[3]); *(u32x2*)((unsigned char*)A + aoff) = w; }
                        else { u32x4 w; w.x = cvt_pk_bf16(a0[0], a0[1]); w.y = cvt_pk_bf16(a0[2], a0[3]); w.z = cvt_pk_bf16(a1[0], a1[1]); w.w = cvt_pk_bf16(a1[2], a1[3]); *(u32x4*)((bf16_t*)A + aoff) = w; }
                        if (bj == 0) ssr[ir] = sq;
                        else {
                            float ss = ssr[ir] + sq;
                            ss += __shfl_xor(ss, 16); ss += __shfl_xor(ss, 32);
                            if (fq == 0) ssq[(unsigned)arow * 32 + u.pn * 4 + wc] = ss;
                        }
                    }
                }
                if (it < 8) {
                    const int ai = it >> 2, m = it & 3;
                    int lr = r0 + ai * HALF + m * 16;
                    if (perm && lat) { const int tp = lr & 8191, j = tp >> 7, i = tp & 127; lr = (lr & ~8191) + i * 64 + j; }
                    const unsigned off = (unsigned)lr * D + c;
                    sv[it % PD][0] = *(const f32x4*)(sB + off); sv[it % PD][1] = *(const f32x4*)(sB + off + 4);
                }
            }
        }
    }
};
typedef EpiResidT<0> EpiResid;
template <bool OUT8> struct EpiSwiglu {
    static constexpr bool PERM = true, AFTER_DRAIN = false;
    void* O; int ntn; float sin;
    const float* ssq; const float* bias; mutable int cur_pm; LAS float* rsl;
    DI void prefetch(const Unit& u, int wid, int lane) const {
        if (!ssq || wid != 0) return;
        const long rb = (long)u.pm * BM; const int bidx = rb < NL ? (int)(rb >> 13) : 4; const int pc = u.pn % ntn;
        __builtin_amdgcn_global_load_lds((const unsigned*)(bias + bidx * FF2 + pc * 128 + (lane & 31) * 4 + (lane >> 5) * FF), (LAS unsigned*)(rsl + 256 + u.par * 256), 16, 0, 0);
    }
    DI void operator()(const Acc& acc, const Unit& u, int wr, int wc, int fr, int fq) const {
        asm volatile("" : "+v"(fr), "+v"(fq));
        const int pc = u.pn % ntn;
        float rs[2][4]; f32x4 ba[2], bb[2];
#pragma unroll
        for (int ai = 0; ai < 2; ++ai)
#pragma unroll
            for (int m = 0; m < 4; ++m) rs[ai][m] = 1.f;
#pragma unroll
        for (int n = 0; n < 2; ++n) { ba[n] = (f32x4){0.f, 0.f, 0.f, 0.f}; bb[n] = ba[n]; }
        if (ssq) {
            const LAS float* bp = rsl + 256 + u.par * 256 + wc * 32 + 8 * fq;
#pragma unroll
            for (int n = 0; n < 2; ++n) { ba[n] = *(const LAS f32x4*)(bp + 4 * n); bb[n] = *(const LAS f32x4*)(bp + 128 + 4 * n) * (OUT8 ? S8_ACT : 1.f); }
            rows_rstd(ssq, rsl, u.pm, cur_pm, wr, wc, fr, fq, rs);
        }
#pragma unroll
        for (int ai = 0; ai < 2; ++ai)
#pragma unroll
            for (int m = 0; m < 4; ++m) {
                const long row = (long)u.pm * BM + ai * HALF + wr * 64 + m * 16 + fr;
                const float sa = sin * rs[ai][m];
                if constexpr (OUT8) {
                    unsigned char* op = (unsigned char*)O + row * FF + pc * 128 + wc * 32 + 8 * fq;
#pragma unroll
                    for (int n = 0; n < 2; ++n) {
                        const f32x4 a = acc[ai][0][m][n] * sa + ba[n], b = acc[ai][1][m][n] * (sa * S8_ACT) + bb[n];
                        *(unsigned*)(op + 4 * n) = pack4_fp8(siluf_(a[0]) * b[0], siluf_(a[1]) * b[1], siluf_(a[2]) * b[2], siluf_(a[3]) * b[3]);
                    }
                    asm volatile("" ::: "memory");
                    continue;
                }
                float o[8];
#pragma unroll
                for (int n = 0; n < 2; ++n)
#pragma unroll
                    for (int q = 0; q < 4; ++q) { const float a = acc[ai][0][m][n][q] * sa + ba[n][q], b = acc[ai][1][m][n][q] * sa + bb[n][q]; o[4 * n + q] = siluf_(a) * b; }
                if constexpr (OUT8) { }
                else *(u32x4*)((bf16_t*)O + row * FF + pc * 128 + wc * 32 + 8 * fq) = pack8(o);
            }
    }
};
struct EpiGlu {
    static constexpr bool PERM = true, AFTER_DRAIN = false;
    const float* YSUM; const float* gb; bf16_t* Y1;
    DI void operator()(const Acc& acc, const Unit& u, int wr, int wc, int fr, int fq) const {
#pragma unroll
        for (int bj = 0; bj < 2; ++bj) {
            const int c0 = u.pn * BM + bj * HALF + wc * 32 + 8 * fq;
            const f32x4 b0 = *(const f32x4*)(gb + c0), b1 = *(const f32x4*)(gb + c0 + 4);
#pragma unroll
            for (int ai = 0; ai < 2; ++ai)
#pragma unroll
                for (int m = 0; m < 4; ++m) {
                    const long row = (long)u.pm * BM + ai * HALF + wr * 64 + m * 16 + fr;
                    const f32x4 y0 = *(const f32x4*)(YSUM + row * 512 + c0), y1 = *(const f32x4*)(YSUM + row * 512 + c0 + 4);
                    float o[8];
#pragma unroll
                    for (int q = 0; q < 4; ++q) { o[q] = y0[q] * sigmoidf_(acc[ai][bj][m][0][q] + b0[q]); o[4 + q] = y1[q] * sigmoidf_(acc[ai][bj][m][1][q] + b1[q]); }
                    *(u32x4*)(Y1 + row * MIX1 + c0) = pack8(o);
                }
        }
    }
};

struct EpiS5A {
    static constexpr bool PERM = true, AFTER_DRAIN = false;
    bf16_t* YI; float* SLOC;
    DI void operator()(const Acc& acc, const Unit& u, int wr, int wc, int fr, int fq) const {
        const int g = u.pn / 3, j = u.pn % 3;
#pragma unroll
        for (int ai = 0; ai < 2; ++ai)
#pragma unroll
            for (int m = 0; m < 4; ++m) {
                const long r = (long)u.pm * BM + ai * HALF + wr * 64 + m * 16 + fr;
#pragma unroll
                for (int bj = 0; bj < 2; ++bj) {
                    const int col0 = bj * HALF + wc * 32 + 8 * fq;
                    const f32x4 v0 = acc[ai][bj][m][0], v1 = acc[ai][bj][m][1];
                    if (j < 2) { u32x4 w; w.x = cvt_pk_bf16(v0[0], v0[1]); w.y = cvt_pk_bf16(v0[2], v0[3]); w.z = cvt_pk_bf16(v1[0], v1[1]); w.w = cvt_pk_bf16(v1[2], v1[3]);
                        *(u32x4*)(YI + ((((long)j * 2304 + r) * 32 + g) << 8) + col0) = w; }
                    else { float* p = SLOC + (((r * 32 + g)) << 8) + col0; *(f32x4*)p = v0; *(f32x4*)(p + 4) = v1; }
                }
            }
    }
};
struct EpiS5C {
    static constexpr bool PERM = true, AFTER_DRAIN = false;
    const bf16_t* YI; float* YS;
    DI void operator()(const Acc& acc, const Unit& u, int wr, int wc, int fr, int fq) const {
        const int d = u.pn >> 5, g = u.pn & 31;
        u32x4 yw[2][4][2];
#pragma unroll
        for (int ai = 0; ai < 2; ++ai)
#pragma unroll
            for (int m = 0; m < 4; ++m)
#pragma unroll
                for (int bj = 0; bj < 2; ++bj) {
                    const long r = (long)u.pm * BM + ai * HALF + wr * 64 + m * 16 + fr;
                    yw[ai][m][bj] = *(const u32x4*)(YI + ((((long)d * 2304 + r) * 32 + g) << 8) + bj * HALF + wc * 32 + 8 * fq);
                }
#pragma unroll
        for (int ai = 0; ai < 2; ++ai)
#pragma unroll
            for (int m = 0; m < 4; ++m) {
                const long r = (long)u.pm * BM + ai * HALF + wr * 64 + m * 16 + fr;
#pragma unroll
                for (int bj = 0; bj < 2; ++bj) {
                    const int col0 = bj * HALF + wc * 32 + 8 * fq, t = col0 >> 4, h0 = col0 & 15;
                    float yi[8]; unpack8(yw[ai][m][bj], yi);
                    const f32x4 v0 = acc[ai][bj][m][0], v1 = acc[ai][bj][m][1];
                    float* p = YS + ((long)d * NL + r * 16 + t) * 512 + g * 16 + h0;
                    *(f32x4*)p = (f32x4){v0[0] + yi[0], v0[1] + yi[1], v0[2] + yi[2], v0[3] + yi[3]};
                    *(f32x4*)(p + 4) = (f32x4){v1[0] + yi[4], v1[1] + yi[5], v1[2] + yi[6], v1[3] + yi[7]};
                }
            }
    }
};

typedef int i32x4v __attribute__((ext_vector_type(4)));
typedef int i32x8v __attribute__((ext_vector_type(8)));
DI i32x8v cat8(bf16x8 lo, bf16x8 hi) { const i32x4v a = __builtin_bit_cast(i32x4v, lo), b = __builtin_bit_cast(i32x4v, hi); return __builtin_shufflevector(a, b, 0, 1, 2, 3, 4, 5, 6, 7); }
template <bool FP8 = false, class Epi, class Sch, bool ALIGN_EPI = true, bool SP2 = true, int AMODE = 0>
DI void gemm_phase(LAS unsigned char* lds, const Gemm g, const Sch& S, const Epi& E) {
    int tid = threadIdx.x; asm volatile("" : "+v"(tid));
    const int wid = __builtin_amdgcn_readfirstlane(tid >> 6), lane = tid & 63, wr = wid >> 2, wc = wid & 3, fr = lane & 15, fq = lane >> 4;
    int K = g.K, lda_ = g.lda, ldb_ = g.ldb; constexpr int amode_ = AMODE; asm volatile("" : "+s"(K), "+s"(lda_), "+s"(ldb_));
    const int nt = K / BK;
    unsigned voffA, voffB;
    { int R, C; stage_rc(tid * 16, R, C); const int Rb = Epi::PERM ? ((R & ~31) + perm32(R & 31)) : R;
        voffA = amode_ ? (unsigned)((R * 16 + (C >> 4)) * lda_ + (C & 15)) * 2u : (unsigned)(R * lda_ + C) * 2u; voffB = (unsigned)(Rb * ldb_ + C) * 2u; }
    const unsigned pstepA = (amode_ ? 16u : 1u) * 64u * lda_ * 2u, pstepB = 64u * ldb_ * 2u;
    const char* const baseA = (const char*)g.A; const char* const baseB = (const char*)g.Bt;
    const unsigned kstep = (unsigned)(BK * 2);
    const unsigned kstepA = amode_ ? 4u * lda_ * 2u : kstep;
    const unsigned hstepA = (amode_ ? 16u : 1u) * HALF * lda_ * 2u, hstepB = (unsigned)HALF * ldb_ * 2u;
    const unsigned ldsw = (unsigned)wid * 1024u;
    const int aoff0 = lds_byte(wr * 64 + fr, fq * 8), boff0 = lds_byte(wc * 32 + fr, fq * 8);
    constexpr int KOFF = 1024;
    const LAS unsigned char* ldsA = lds + aoff0; const LAS unsigned char* ldsB = lds + boff0;
#define PG8_SA(b, h) (((b) * 2 + (h)) * HTB)
#define PG8_SB(b, h) ((4 + (b) * 2 + (h)) * HTB)
#define PG8_STAGE(bufoff, gbase, voff) do { _Pragma("unroll") for (int _i = 0; _i < 2; ++_i) { unsigned _vo = (voff); if constexpr (FP8) asm volatile("" : "+v"(_vo)); \
        __builtin_amdgcn_global_load_lds((const unsigned*)(base_##voff + (unsigned)((gbase) + _i * pstep_##voff + _vo)), (LAS unsigned*)(lds + (bufoff) + ldsw + _i * 8192), 16, 0, 0); } } while (0)
#define pstep_voffA pstepA
#define pstep_voffB pstepB
#define base_voffA baseA
#define base_voffB baseB
#define PG8_LDA(dst, b, h) do { _Pragma("unroll") for (int m = 0; m < 4; ++m) { \
        if constexpr (FP8) { dst##8[m].lo = *(const LAS i32x4v*)(ldsA + PG8_SA(b, h) + m * 2048); dst##8[m].hi = *(const LAS i32x4v*)(ldsA + PG8_SA(b, h) + KOFF + m * 2048); } \
        else { _Pragma("unroll") for (int k = 0; k < 2; ++k) dst[m][k] = *(const LAS bf16x8*)(ldsA + PG8_SA(b, h) + k * KOFF + m * 2048); } } } while (0)
#define PG8_LDB(dst, b, h) do { _Pragma("unroll") for (int n = 0; n < 2; ++n) { \
        if constexpr (FP8) { dst##8[n].lo = *(const LAS i32x4v*)(ldsB + PG8_SB(b, h) + n * 2048); dst##8[n].hi = *(const LAS i32x4v*)(ldsB + PG8_SB(b, h) + KOFF + n * 2048); } \
        else { _Pragma("unroll") for (int k = 0; k < 2; ++k) dst[n][k] = *(const LAS bf16x8*)(ldsB + PG8_SB(b, h) + k * KOFF + n * 2048); } } } while (0)
#define PG8_MMA(ai, bj, At, Bt) do { __builtin_amdgcn_s_setprio(1); _Pragma("unroll") for (int m = 0; m < 4; ++m) _Pragma("unroll") for (int n = 0; n < 2; ++n) { \
        if constexpr (FP8) asm volatile("v_mfma_f32_16x16x128_f8f6f4 %0, %1, %2, %0" : "+v"(acc[ai][bj][m][n]) : "v"(Bt##8[n]), "v"(At##8[m]));   \
        else { _Pragma("unroll") for (int k = 0; k < 2; ++k) acc[ai][bj][m][n] = __builtin_amdgcn_mfma_f32_16x16x32_bf16(Bt[n][k], At[m][k], acc[ai][bj][m][n], 0, 0, 0); } } \
        __builtin_amdgcn_s_setprio(0); } while (0)
#define PG8_WAIT_V(n) asm volatile("s_waitcnt vmcnt(" #n ")" ::: "memory")
#define PG8_WAIT_L(n) asm volatile("s_waitcnt lgkmcnt(" #n ")" ::: "memory")
#define PG8_BAR __builtin_amdgcn_s_barrier()
#define PG8_SCHED __builtin_amdgcn_sched_barrier(0)
    Unit cur, nxt; int ui = 0;
    if (!S.next(0, cur)) return;
    Acc acc;
#pragma unroll
    for (int a = 0; a < 2; ++a)
#pragma unroll
        for (int b = 0; b < 2; ++b)
#pragma unroll
            for (int m = 0; m < 4; ++m)
#pragma unroll
                for (int n = 0; n < 2; ++n) acc[a][b][m][n] = (f32x4){0.f, 0.f, 0.f, 0.f};
    bf16x8 At[4][2], B0[2][2], B1[2][2];
    i32x8v At8[4], B08[2], B18[2];
    (void)At; (void)B0; (void)B1; (void)At8; (void)B08; (void)B18;
    unsigned cA = (unsigned)cur.aoff, cB = (unsigned)cur.boff;
    S.a_ready(cur);
    cur.par = 0; if constexpr (has_prefetch<Epi>::value) E.prefetch(cur, wid, lane);
    if constexpr (SP2) {
        PG8_STAGE(PG8_SB(0, 0), cB, voffB); PG8_STAGE(PG8_SB(0, 1), cB + hstepB, voffB); PG8_STAGE(PG8_SA(0, 0), cA, voffA); PG8_STAGE(PG8_SA(0, 1), cA + hstepA, voffA);
        if (wr == 1) PG8_BAR;
        PG8_WAIT_V(2); PG8_BAR;
        PG8_STAGE(PG8_SB(1, 0), cB + kstep, voffB); PG8_STAGE(PG8_SA(1, 0), cA + kstepA, voffA); PG8_STAGE(PG8_SB(1, 1), cB + hstepB + kstep, voffB);
        PG8_WAIT_V(6); PG8_BAR;
    } else {
        PG8_STAGE(PG8_SB(0, 0), cB, voffB); PG8_STAGE(PG8_SA(0, 0), cA, voffA); PG8_STAGE(PG8_SB(0, 1), cB + hstepB, voffB); PG8_STAGE(PG8_SA(0, 1), cA + hstepA, voffA);
        if (wr == 1) PG8_BAR;
        PG8_WAIT_V(4); PG8_BAR;
        PG8_STAGE(PG8_SB(1, 0), cB + kstep, voffB); PG8_STAGE(PG8_SA(1, 0), cA + kstepA, voffA); PG8_STAGE(PG8_SB(1, 1), cB + hstepB + kstep, voffB);
        PG8_WAIT_V(6); PG8_BAR;
    }
    for (;;) {
        const bool has_next = S.next(ui + 1, nxt); nxt.par = (ui + 1) & 1;
        const unsigned nA = has_next ? (unsigned)nxt.aoff : cA, nB = has_next ? (unsigned)nxt.boff : cB;
        for (int t = 0; t < nt; t += 2) {
            const bool last = (t == nt - 2);
            const unsigned a1 = cA + (unsigned)(t + 1) * kstepA;
            const unsigned a2 = last ? nA : cA + (unsigned)(t + 2) * kstepA, b2 = last ? nB : cB + (unsigned)(t + 2) * kstep;
            const unsigned a3 = a2 + kstepA, b3 = b2 + kstep;
            if (last && has_next) { S.a_ready(nxt); if constexpr (has_prefetch<Epi>::value) E.prefetch(nxt, wid, lane); }
            if constexpr (SP2) {
            PG8_LDB(B0, 0, 0); PG8_LDB(B1, 0, 1); PG8_SCHED; PG8_LDA(At, 0, 0); PG8_STAGE(PG8_SA(1, 1), a1 + hstepA, voffA);
            PG8_WAIT_V(8); PG8_WAIT_L(0); PG8_BAR; PG8_MMA(0, 0, At, B0); PG8_MMA(0, 1, At, B1); PG8_BAR; PG8_SCHED;
            PG8_LDA(At, 0, 1); PG8_STAGE(PG8_SB(0, 0), b2, voffB); PG8_STAGE(PG8_SB(0, 1), b2 + hstepB, voffB); PG8_STAGE(PG8_SA(0, 0), a2, voffA);
            PG8_WAIT_V(8); PG8_WAIT_L(0); PG8_BAR; PG8_MMA(1, 0, At, B0); PG8_MMA(1, 1, At, B1); PG8_BAR; PG8_SCHED;
            PG8_LDB(B0, 1, 0); PG8_LDB(B1, 1, 1); PG8_SCHED; PG8_LDA(At, 1, 0); PG8_STAGE(PG8_SA(0, 1), a2 + hstepA, voffA);
            PG8_WAIT_V(8); PG8_WAIT_L(0); PG8_BAR; PG8_MMA(0, 0, At, B0); PG8_MMA(0, 1, At, B1); PG8_BAR; PG8_SCHED;
            PG8_LDA(At, 1, 1); PG8_STAGE(PG8_SB(1, 0), b3, voffB); PG8_STAGE(PG8_SB(1, 1), b3 + hstepB, voffB); PG8_STAGE(PG8_SA(1, 0), a3, voffA);
            PG8_WAIT_V(8); PG8_WAIT_L(0); PG8_BAR; PG8_MMA(1, 0, At, B0); PG8_MMA(1, 1, At, B1); PG8_BAR; PG8_SCHED;
            } else {
            PG8_LDB(B0, 0, 0); PG8_SCHED; PG8_LDA(At, 0, 0); PG8_STAGE(PG8_SA(1, 1), a1 + hstepA, voffA);
            PG8_WAIT_L(8); PG8_BAR; PG8_WAIT_L(0); PG8_MMA(0, 0, At, B0); PG8_BAR; PG8_SCHED;
            PG8_LDB(B1, 0, 1); PG8_STAGE(PG8_SB(0, 0), b2, voffB);
            PG8_BAR; PG8_WAIT_L(0); PG8_MMA(0, 1, At, B1); PG8_BAR;
            PG8_LDA(At, 0, 1); PG8_STAGE(PG8_SA(0, 0), a2, voffA);
            PG8_BAR; PG8_WAIT_L(0); PG8_MMA(1, 0, At, B0); PG8_BAR; PG8_SCHED;
            PG8_STAGE(PG8_SB(0, 1), b2 + hstepB, voffB);
            PG8_WAIT_V(6); PG8_BAR; PG8_MMA(1, 1, At, B1); PG8_BAR;
            PG8_LDB(B0, 1, 0); PG8_SCHED; PG8_LDA(At, 1, 0); PG8_STAGE(PG8_SA(0, 1), a2 + hstepA, voffA);
            PG8_WAIT_L(8); PG8_BAR; PG8_WAIT_L(0); PG8_MMA(0, 0, At, B0); PG8_BAR; PG8_SCHED;
            PG8_LDB(B1, 1, 1); PG8_STAGE(PG8_SB(1, 0), b3, voffB);
            PG8_BAR; PG8_WAIT_L(0); PG8_MMA(0, 1, At, B1); PG8_BAR;
            PG8_LDA(At, 1, 1); PG8_STAGE(PG8_SA(1, 0), a3, voffA);
            PG8_BAR; PG8_WAIT_L(0); PG8_MMA(1, 0, At, B0); PG8_BAR; PG8_SCHED;
            PG8_STAGE(PG8_SB(1, 1), b3 + hstepB, voffB);
            PG8_WAIT_V(6); PG8_BAR; PG8_MMA(1, 1, At, B1); PG8_BAR;
            }
        }
        if constexpr (ALIGN_EPI) { if (wr == 0) PG8_BAR; }
        if constexpr (FP8) asm volatile("s_nop 15\n\ts_nop 15" ::: "memory");
        { int fr2 = fr, fq2 = fq; asm volatile("" : "+v"(fr2), "+v"(fq2));
          E(acc, cur, wr, wc, fr2, fq2); } S.done(cur);
        if (!has_next) break;
#pragma unroll
        for (int a = 0; a < 2; ++a)
#pragma unroll
            for (int b = 0; b < 2; ++b)
#pragma unroll
                for (int m = 0; m < 4; ++m)
#pragma unroll
                    for (int n = 0; n < 2; ++n) acc[a][b][m][n] = (f32x4){0.f, 0.f, 0.f, 0.f};
        cur = nxt; cA = nA; cB = nB; ++ui;
        if constexpr (ALIGN_EPI) { if (wr == 1) PG8_BAR; }
    }
    PG8_WAIT_V(0);
    if constexpr (!ALIGN_EPI) { if (wr == 0) PG8_BAR; }
    PG8_BAR;
#undef PG8_SA
#undef PG8_SB
#undef PG8_STAGE
#undef pstep_voffA
#undef pstep_voffB
#undef base_voffA
#undef base_voffB
#undef PG8_LDA
#undef PG8_LDB
#undef PG8_MMA
#undef PG8_WAIT_V
#undef PG8_WAIT_L
#undef PG8_BAR
#undef PG8_SCHED
}
}

#define XB_TMO      128
#define XB_XCNT(j)  (256  + 64 * (j))
#define XB_XSUB(j)  (1280 + 64 * (j))
#define XB_XGEN(j)  (2304 + 64 * (j))
#define XB_TOP      3328
#define XB_TOPGEN   3392
#define XCD_BAR_WORDS 3456
#define XB_SPIN_CAP (1u << 24)
DI unsigned xb_ld(unsigned* p)              { return __hip_atomic_load(p, __ATOMIC_RELAXED, __HIP_MEMORY_SCOPE_AGENT); }
DI unsigned xb_add(unsigned* p, unsigned v) { return __hip_atomic_fetch_add(p, v, __ATOMIC_RELAXED, __HIP_MEMORY_SCOPE_AGENT); }
DI unsigned xb_xcc_id() { return (unsigned)__builtin_amdgcn_s_getreg((3 << 11) | 20) & 0xFu; }
#define XB_SPIN(cond, bar) do { unsigned _sp = 0; while (cond) { __builtin_amdgcn_s_sleep(1); \
    if ((++_sp & 255u) == 0u) { if (xb_ld(&(bar)[XB_TMO])) break; if (_sp > XB_SPIN_CAP) { atomicAdd(&(bar)[XB_TMO], 1u); break; } } } } while (0)
struct XcdBarrier { unsigned* bar; unsigned x; volatile LAS unsigned* st; };
DI XcdBarrier xcd_barrier_post(unsigned* bar, volatile LAS unsigned* st) {
    XcdBarrier b; b.bar = bar; b.x = xb_xcc_id(); b.st = st;
    if (threadIdx.x == 0) (void)xb_add(&bar[XB_XCNT(b.x)], 1u);
    return b;
}
DI void xcd_barrier_complete(unsigned* bar, unsigned x, unsigned& nloc, unsigned& nx) {
    const unsigned G = gridDim.x * gridDim.y * gridDim.z;
    unsigned sum, cnt, mine, sp = 0u;
    for (;;) {
        sum = 0u; cnt = 0u; mine = 0u;
#pragma unroll
        for (unsigned j = 0; j < 16; ++j) { const unsigned c = xb_ld(&bar[XB_XCNT(j)]); sum += c; cnt += (c > 0u) ? 1u : 0u; mine = (j == x) ? c : mine; }
        if (sum == G) break;
        __builtin_amdgcn_s_sleep(1);
        if ((++sp & 255u) == 0u) { if (xb_ld(&bar[XB_TMO])) break; if (sp > XB_SPIN_CAP) { atomicAdd(&bar[XB_TMO], 1u); break; } }
    }
    nloc = mine > 0u ? mine : 1u; nx = cnt > 0u ? cnt : 1u;
}
DI void xcd_barrier(const XcdBarrier& b) {
    asm volatile("s_waitcnt vmcnt(0)" ::: "memory");
    __syncthreads();
    if (threadIdx.x == 0) {
        unsigned* bar = b.bar;
        __builtin_amdgcn_s_waitcnt(0);
        unsigned nloc = b.st[0], nx = b.st[1];
        if (nloc == 0u) { xcd_barrier_complete(bar, b.x, nloc, nx); b.st[0] = nloc; b.st[1] = nx; }
        const unsigned old = xb_add(&bar[XB_XSUB(b.x)], 1u);
        const unsigned gen = old / nloc;
        if (old + 1u == (gen + 1u) * nloc) {
            __builtin_amdgcn_fence(__ATOMIC_RELEASE, "agent");
            asm volatile("s_waitcnt vmcnt(0)" ::: "memory");
            const unsigned og = xb_add(&bar[XB_TOP], 1u);
            const unsigned tg = og / nx;
            if (og + 1u == (tg + 1u) * nx) xb_add(&bar[XB_TOPGEN], 1u);
            else XB_SPIN(xb_ld(&bar[XB_TOPGEN]) == tg, bar);
            __builtin_amdgcn_fence(__ATOMIC_ACQUIRE, "agent");
            xb_add(&bar[XB_XGEN(b.x)], 1u);
            asm volatile("s_waitcnt vmcnt(0)" ::: "memory");
        } else {
            XB_SPIN(xb_ld(&bar[XB_XGEN(b.x)]) == gen, bar);
            __builtin_amdgcn_fence(__ATOMIC_ACQUIRE, "agent");
            asm volatile("s_waitcnt vmcnt(0)" ::: "memory");
        }
    }
    __syncthreads();
}

struct Params { const float* in[N_IN]; float* out; unsigned char* ws; int lo, hi, li, pad; };
static_assert(sizeof(Params) == (N_IN + 2) * 8 + 16, "Params has no padding");

struct Frame {
    LAS unsigned char* lds;
    int tid, lane, wave, G, bid;
    const float* const* in; float* out; unsigned char* ws;
};
#define WSP(T_, off) ((T_*)(F.ws + (off)))

struct TrJob { const float* src; unsigned char* dst; int K, N, r0, k0; float sc; int out8; };
DI void tr_load(const TrJob& j, int lane, float (&v)[32]) {
#pragma unroll
    for (int i = 0; i < 32; ++i) v[i] = j.src[(size_t)(2 * i + (lane >> 5)) * j.N + (lane & 31)];
}
DI void tr_store(const TrJob& j, int lane, const float (&v)[32], LAS float* scr) {
#pragma unroll
    for (int i = 0; i < 32; ++i) scr[(2 * i + (lane >> 5)) * 33 + (lane & 31)] = v[i];
    asm volatile("s_waitcnt lgkmcnt(0)" ::: "memory");
    const int c = lane & 7;
#pragma unroll
    for (int q = 0; q < 4; ++q) { const int n = (lane >> 3) + 8 * q; const LAS float* sp = scr + (8 * c) * 33 + n;
        if (j.out8) { const float sc = j.sc; u32x2 o; o.x = pack4_fp8(sp[0 * 33] * sc, sp[1 * 33] * sc, sp[2 * 33] * sc, sp[3 * 33] * sc); o.y = pack4_fp8(sp[4 * 33] * sc, sp[5 * 33] * sc, sp[6 * 33] * sc, sp[7 * 33] * sc);
            *(u32x2*)(j.dst + (size_t)(j.r0 + n) * j.K + j.k0 + 8 * c) = o; }
        else { u32x4 o; o.x = cvt_pk_bf16(sp[0 * 33], sp[1 * 33]); o.y = cvt_pk_bf16(sp[2 * 33], sp[3 * 33]); o.z = cvt_pk_bf16(sp[4 * 33], sp[5 * 33]); o.w = cvt_pk_bf16(sp[6 * 33], sp[7 * 33]);
            *(u32x4*)((bf16_t*)j.dst + (size_t)(j.r0 + n) * j.K + j.k0 + 8 * c) = o; } }
    asm volatile("s_waitcnt lgkmcnt(0)" ::: "memory");
}
DI TrJob tr_make(const float* W, int K, int N, void* WT, int row_off, int mode, int item, int out8, float sc) {
    const int nblk = N / 32, kb = item / nblk, nb = item % nblk; const int n0 = nb * 32;
    int r0;
    if (mode == 0) r0 = row_off + n0;
    else { const int half = n0 >= FF ? 1 : 0; const int nn = n0 - half * FF; r0 = row_off + (nn >> 7) * 256 + half * 128 + (nn & 127); }
    TrJob j; j.src = W + (size_t)(64 * kb) * N + n0; j.dst = (unsigned char*)WT; j.K = K; j.N = N; j.r0 = r0; j.k0 = 64 * kb; j.sc = sc; j.out8 = out8; return j;
}
namespace trc {
constexpr int J_IN0 = (D / 64) * (IN0 / 32), J_OUT0 = (D / 64) * (D / 32), J_FWI = (D / 64) * (FF2 / 32), J_FWO = (FF / 64) * (D / 32),
              J_IN1 = (D / 64) * (IN1 / 32), J_OUT1 = (MIX1 / 64) * (D / 32), J_GLU = (512 / 64) * (512 / 32), J_RG1 = (128 / 64) * (128 / 32), J_QKV1 = (256 / 64) * (256 / 32);
constexpr int TR_MOE = 8 * J_FWI + 8 * J_FWO;
constexpr int NITEMS = TR_MOE + J_IN0 + J_OUT0 + J_FWI + J_FWO + J_IN1 + J_OUT1 + J_GLU + 32 * J_RG1 + 12 * J_QKV1;
}
DI TrJob tr_job_of(Frame& F, int it) {
    using namespace trc;
    int r = it;
    if (r < 8 * J_FWI) { const int e = r / J_FWI; return tr_make(F.in[I1_MWI] + (size_t)e * D * FF2, D, FF2, WSP(unsigned char, WT_MWI) + (size_t)e * FF2 * D * (FP8_MOE ? 1 : 2), 0, 1, r % J_FWI, FP8_MOE, S8_W1); } r -= 8 * J_FWI;
    if (r < 8 * J_FWO) { const int e = r / J_FWO; return tr_make(F.in[I1_MWO] + (size_t)e * FF * D, FF, D, WSP(unsigned char, WT_MWO) + (size_t)e * D * FF * (FP8_MOE ? 1 : 2), 0, 0, r % J_FWO, FP8_MOE, S8_W2); } r -= 8 * J_FWO;
    if (r < J_IN0) return tr_make(F.in[I0_WIN], D, IN0, WSP(bf16_t, WT_IN0), 0, 0, r, 0, 1.f); r -= J_IN0;
    if (r < J_OUT0) return tr_make(F.in[I0_WOUT], D, D, WSP(bf16_t, WT_OUT0), 0, 0, r, 0, 1.f); r -= J_OUT0;
    if (r < J_FWI) return tr_make(F.in[I0_FWI], D, FF2, WSP(unsigned char, WT_FWI0), 0, 1, r, FP8_FFN, S8_W1); r -= J_FWI;
    if (r < J_FWO) return tr_make(F.in[I0_FWO], FF, D, WSP(unsigned char, WT_FWO0), 0, 0, r, FP8_FFN, S8_W2); r -= J_FWO;
    if (r < J_IN1) return tr_make(F.in[I1_WIN], D, IN1, WSP(bf16_t, WT_IN1), 0, 0, r, 0, 1.f); r -= J_IN1;
    if (r < J_OUT1) return tr_make(F.in[I1_WOUT], MIX1, D, WSP(bf16_t, WT_OUT1), 0, 0, r, 0, 1.f); r -= J_OUT1;
    if (r < J_GLU) return tr_make(F.in[I1_GLUW], 512, 512, WSP(bf16_t, WT_GLU), 0, 0, r, 0, 1.f); r -= J_GLU;
    if (r < 32 * J_RG1) { const int j = r / J_RG1, which = j >> 4, d = (j >> 3) & 1, blk = j & 7;
        return tr_make(F.in[which ? I0_AWI : I0_AWR] + (size_t)(d * 8 + blk) * 128 * 128, 128, 128, WSP(bf16_t, WT_RG), blk * 512 + d * 256 + which * 128, 0, r % J_RG1, 0, 1.f); } r -= 32 * J_RG1;
    const int j = r / J_QKV1, which = j >> 2, h = j & 3;
    const float* src = F.in[which == 0 ? I0_BWQ : (which == 1 ? I0_BWK : I0_BWV)] + (size_t)h * 256 * 256;
    if (which < 2) return tr_make(src, 256, 256, WSP(bf16_t, WT_QK), h * 512 + which * 256, 0, r % J_QKV1, 0, 1.f);
    return tr_make(src, 256, 256, WSP(bf16_t, WT_V), h * 256, 0, r % J_QKV1, 0, 1.f);
}
DI void tr_run(Frame& F, int first, int end, int stride) {
    LAS float* scr = (LAS float*)(F.lds + F.wave * 16384);
    if (first >= end) return;
    TrJob cur = tr_job_of(F, first); float v[32]; tr_load(cur, F.lane, v);
    for (int it = first; it < end; it += stride) {
        const int nit = it + stride; TrJob nxt = cur; float w[32];
        if (nit < end) { nxt = tr_job_of(F, nit); tr_load(nxt, F.lane, w); }
        tr_store(cur, F.lane, v, scr);
        if (nit < end) {
#pragma unroll
            for (int i = 0; i < 32; ++i) v[i] = w[i];
            cur = nxt; }
    }
}
constexpr int TQ_IN0 = 88, TQ_OUT0 = 88, TQ_FWI = 40, TQ_FWO = 104, TQ_IN1 = 88;
constexpr int TB_IN0 = 0, TB_OUT0 = TB_IN0 + 192 * TQ_IN0, TB_FWI = TB_OUT0 + 224 * TQ_OUT0, TB_FWO = TB_FWI + 80 * TQ_FWI, TB_IN1 = TB_FWO + 224 * TQ_FWO, TR_DEFER = TB_IN1 + 68 * TQ_IN1;
static_assert(TR_DEFER <= trc::TR_MOE, "deferred items are expert-weight items");
DI void tail_convert(Frame& F, int nwg, int base, int quota) {
    if (F.G != 256) return;
    const int r = nwg % 256; if (r == 0 || F.bid < r) return;
    const int lo = base + (F.bid - r) * quota;
    tr_run(F, lo + F.wave, lo + quota, 8);
    __syncthreads();
}
DI void s5_build_unit(Frame& F, int u);
DI void phase_prologue(Frame& F) {
    {
        LAS float* cact = (LAS float*)F.lds;
        LAS float* red = (LAS float*)(F.lds + 40960);
        bool have = false;
        for (int u = F.bid; u < 2 * 96; u += F.G) {
            if (!have) {
                { float tv[20];
#pragma unroll
                  for (int j = 0; j < 20; ++j) { const int i = F.tid + 512 * j, r = i >> 11, k = i & 2047; tv[j] = r < 4 ? F.in[I_C][r * 2048 + k] : F.in[I_CCTX][k]; }
#pragma unroll
                  for (int j = 0; j < 20; ++j) cact[F.tid + 512 * j] = siluf_(tv[j]); }
                have = true; __syncthreads();
            }
            const int l = u / 96, cb = u % 96;
            const float* W = F.in[l ? I1_MODW : I0_MODW]; const float* Bv = F.in[l ? I1_MODB : I0_MODB];
            const int cg = F.tid & 31, ks = F.tid >> 5;
            float acc[5][4];
#pragma unroll
            for (int r = 0; r < 5; ++r)
#pragma unroll
                for (int q = 0; q < 4; ++q) acc[r][q] = 0.f;
            const float* wp = W + (size_t)(ks * 128) * 12288 + cb * 128 + cg * 4;
#pragma unroll 4
            for (int k = 0; k < 128; ++k) {
                const f32x4 w = *(const f32x4*)(wp + (size_t)k * 12288);
#pragma unroll
                for (int r = 0; r < 5; ++r) { const float a = cact[r * 2048 + ks * 128 + k]; acc[r][0] += a * w[0]; acc[r][1] += a * w[1]; acc[r][2] += a * w[2]; acc[r][3] += a * w[3]; }
            }
#pragma unroll
            for (int r = 0; r < 5; ++r)
#pragma unroll
                for (int q = 0; q < 4; ++q) red[(ks * 5 + r) * 128 + cg * 4 + q] = acc[r][q];
            __syncthreads();
            for (int i = F.tid; i < 5 * 128; i += 512) { const int r = i >> 7, c = i & 127; float s = 0.f;
#pragma unroll
                for (int k2 = 0; k2 < 16; ++k2) s += red[(k2 * 5 + r) * 128 + c];
                WSP(float, WS_MOD)[(l * 5 + r) * 12288 + cb * 128 + c] = s + Bv[cb * 128 + c]; }
            __syncthreads();
        }
        __syncthreads();
    }
    {
        for (int u = F.G - 1 - F.bid; u < 64; u += F.G) s5_build_unit(F, u);
        const int gt = F.bid * 512 + F.tid, GT = F.G * 512;
        bf16_t* GTW = WSP(bf16_t, WT_GT);
        for (int i = gt; i < 256 * 1024; i += GT) { const int r = i >> 10, k = i & 1023; float v = 0.f; if (r < 16) v = F.in[I0_BWIF][((r >> 3) * 1024 + k) * 8 + (r & 7)]; GTW[i] = f2bf(v); }
    }
    {
        __syncthreads();
        const int gw = F.bid * 8 + F.wave, NGW = F.G * 8;
        const int first = (F.G == 256) ? TR_DEFER : 0;
        tr_run(F, first + gw, trc::NITEMS, NGW);
    }
}

DI void s5_build_unit(Frame& F, int u) {
    const int d = u >> 5, g = u & 31;
    LAS float* pwr = (LAS float*)F.lds;
    LAS float* pwi = pwr + 17 * 64;
    LAS float* bbr = pwi + 17 * 64;
    LAS float* bbi = bbr + 64 * 16;
    LAS float* cr = bbi + 64 * 16;
    LAS float* ci = cr + 16 * 64;
    LAS float* kt = ci + 16 * 64;
    __syncthreads();
    if (F.tid < 64) {
        const int p = F.tid, i = (d * 32 + g) * 64 + p;
        const float dt = expf(F.in[I1_LDT][d * 32 + g]);
        const float lr = F.in[I1_LRE][i], lim = F.in[I1_LIM][i];
        for (int tau = 0; tau <= 16; ++tau) { const float mag = expf(lr * dt * (float)tau), ang = lim * dt * (float)tau; pwr[tau * 64 + p] = mag * cosf(ang); pwi[tau * 64 + p] = mag * sinf(ang); }
        const float ab_re = pwr[64 + p], ab_im = pwi[64 + p];
        const float den = lr * lr + lim * lim; const float nr = ab_re - 1.f, ni = ab_im;
        const float co_re = (nr * lr + ni * lim) / den, co_im = (ni * lr - nr * lim) / den;
        const float* bre = F.in[I1_BRE] + (g * 64 + p) * 16; const float* bim = F.in[I1_BIM] + (g * 64 + p) * 16;
        for (int h = 0; h < 16; ++h) { bbr[p * 16 + h] = co_re * bre[h] - co_im * bim[h]; bbi[p * 16 + h] = co_re * bim[h] + co_im * bre[h]; }
        WSP(float, WS_S5AB)[i * 2] = pwr[16 * 64 + p]; WSP(float, WS_S5AB)[i * 2 + 1] = pwi[16 * 64 + p];
    }
    for (int i = F.tid; i < 16 * 64; i += 512) { cr[i] = F.in[I1_CRE][(d * 32 + g) * 1024 + i]; ci[i] = F.in[I1_CIM][(d * 32 + g) * 1024 + i]; }
    __syncthreads();
    for (int e = F.tid; e < 4096; e += 512) {
        const int lag = e >> 8, h = (e >> 4) & 15, hp = e & 15; float acc = 0.f;
        for (int p = 0; p < 64; ++p) { const float ar = pwr[lag * 64 + p], ai = pwi[lag * 64 + p], br = bbr[p * 16 + hp], bi = bbi[p * 16 + hp];
            acc += cr[h * 64 + p] * (ar * br - ai * bi) - ci[h * 64 + p] * (ar * bi + ai * br); }
        kt[e] = acc;
    }
    __syncthreads();
    bf16_t* W1 = WSP(bf16_t, WT_S5W1) + (size_t)g * 768 * 256;
    for (int idx = F.tid; idx < 65536; idx += 512) {
        const int n = idx >> 8, k = idx & 255, t = n >> 4, h = n & 15, j = k >> 4, hp = k & 15; const int lag = d ? (j - t) : (t - j);
        W1[(size_t)(d * 256 + n) * 256 + k] = f2bf(lag >= 0 ? kt[(lag * 16 + h) * 16 + hp] : 0.f);
    }
    for (int idx = F.tid; idx < 32768; idx += 512) {
        const int n = idx >> 8, k = idx & 255, p = n & 63, j = k >> 4, hp = k & 15; const int lag = d ? j : (15 - j);
        const float ar = pwr[lag * 64 + p], ai = pwi[lag * 64 + p], br = bbr[p * 16 + hp], bi = bbi[p * 16 + hp];
        W1[(size_t)(512 + d * 128 + n) * 256 + k] = f2bf(n < 64 ? (ar * br - ai * bi) : (ar * bi + ai * br));
    }
    bf16_t* W3 = WSP(bf16_t, WT_S5W3) + (size_t)(d * 32 + g) * 256 * 128;
    for (int idx = F.tid; idx < 32768; idx += 512) {
        const int n = idx >> 7, k = idx & 127, t = n >> 4, h = n & 15, p = k & 63; const int lag = d ? (16 - t) : (t + 1);
        const float ar = pwr[lag * 64 + p], ai = pwi[lag * 64 + p], c_r = cr[h * 64 + p], c_i = ci[h * 64 + p];
        W3[(size_t)n * 128 + k] = f2bf(k < 64 ? (c_r * ar - c_i * ai) : -(c_r * ai + c_i * ar));
    }
    __syncthreads();
}
DI int s5_chunk_row(int d, int b, int step) {
    if (step < 16) { const int cc = d ? 15 - step : step; return 2048 + b * 16 + cc; }
    const int st = step - 16; const int cc = d ? 511 - st : st; return b * 512 + cc;
}
DI void phase_s5_carry(Frame& F) {
    const float* SLOC = WSP(float, A_SLOC); bf16_t* SIN = WSP(bf16_t, A_SIN);
    for (int id = F.bid + F.G * F.wave; id < 256; id += F.G * 8) {
        const int g = id & 31, b = (id >> 5) & 3, d = id >> 7, p = F.lane;
        const int si = (d * 32 + g) * 64 + p;
        const float a_re = WSP(float, WS_S5AB)[si * 2], a_im = WSP(float, WS_S5AB)[si * 2 + 1];
        float s_re = 0.f, s_im = 0.f;
        bf16_t* sin_dg = SIN + (size_t)(d * 32 + g) * S5ROWS * 128;
        for (int st0 = 0; st0 < 528; st0 += 16) {
            float lr[16], li[16]; int rr[16];
#pragma unroll
            for (int q = 0; q < 16; ++q) { rr[q] = s5_chunk_row(d, b, st0 + q); const float* sl = SLOC + (((size_t)rr[q] * 32 + g) << 8) + d * 128; lr[q] = sl[p]; li[q] = sl[64 + p]; }
#pragma unroll
            for (int q = 0; q < 16; ++q) {
                if (rr[q] < 2048) { sin_dg[(size_t)rr[q] * 128 + p] = f2bf(s_re); sin_dg[(size_t)rr[q] * 128 + 64 + p] = f2bf(s_im); }
                const float nr = a_re * s_re - a_im * s_im + lr[q], ni = a_re * s_im + a_im * s_re + li[q];
                s_re = nr; s_im = ni;
            }
        }
    }
}

template <bool OUT8 = false> DI void phase_norm(Frame& F, const float* srcL, const float* srcC, const float* gamma, const float* modl, int sh_off, int sc_off, void* H, bool permute, int nrows) {
    const int gw = F.bid * 8 + F.wave, NGW = F.G * 8;
    for (int row = gw; row < nrows; row += NGW) {
        const float* src = row < NL ? srcL + (size_t)row * D : srcC + (size_t)(row - NL) * D;
        const int bidx = row < NL ? (row >> 13) : 4;
        int drow = row;
        if (permute && row < NL) { const int t = row & 8191, i = t >> 6, j = t & 63; drow = (row & ~8191) + j * 128 + i; }
        const f32x4* xr = (const f32x4*)src + F.lane;
        f32x4 v[8]; float ss = 0.f;
#pragma unroll
        for (int j = 0; j < 8; ++j) { v[j] = xr[64 * j]; ss += (v[j].x * v[j].x + v[j].y * v[j].y) + (v[j].z * v[j].z + v[j].w * v[j].w); }
        const float rstd = rsqrtf(wave_sum(ss) * (1.f / D) + EPS);
        const f32x4* gp = (const f32x4*)gamma + F.lane; const f32x4* scp = (const f32x4*)(modl + bidx * 12288 + sc_off) + F.lane; const f32x4* shp = (const f32x4*)(modl + bidx * 12288 + sh_off) + F.lane;
        u32x2* o8 = (u32x2*)((bf16_t*)H + (size_t)drow * D) + F.lane; unsigned* o4 = (unsigned*)((unsigned char*)H + (size_t)drow * D) + F.lane;
#pragma unroll
        for (int j = 0; j < 8; ++j) {
            const f32x4 g = gp[64 * j], sc = scp[64 * j], sh = shp[64 * j];
            const f32x4 y = v[j] * rstd * g * (sc + 1.f) + sh;
            if constexpr (OUT8) o4[64 * j] = pack4_fp8(y.x * S8_H, y.y * S8_H, y.z * S8_H, y.w * S8_H);
            else { u32x2 w; w.x = cvt_pk_bf16(y.x, y.y); w.y = cvt_pk_bf16(y.z, y.w); o8[64 * j] = w; }
        }
    }
}

constexpr int NBC_FFN = FF2 / 512, NBC_IN1 = (IN1 + 511) / 512, NB_UNITS = 8 * (NBC_FFN + NBC_IN1);
DI void phase_bias(Frame& F) {
    LAS float* cact = (LAS float*)F.lds;
    LAS float* red = (LAS float*)(F.lds + 8192);
    for (int u = F.G - 1 - F.bid; u < NB_UNITS; u += F.G) {
        const int kind = u >= 8 * NBC_FFN ? 1 : 0, uu = kind ? u - 8 * NBC_FFN : u, cb = uu >> 3, kb = uu & 7;
        __syncthreads();
        { const float* mv = WSP(float, WS_MOD) + (kind ? 5 * 12288 : 6144) + kb * 256;
#pragma unroll
          for (int j = 0; j < 3; ++j) { const int i = F.tid + 512 * j; if (i < 5 * 256) cact[i] = mv[(i >> 8) * 12288 + (i & 255)]; } }
        __syncthreads();
        const int N = kind ? IN1 : FF2, ldo = kind ? IN1P : FF2;
        const float* W = F.in[kind ? I1_WIN : I0_FWI]; float* PB = WSP(float, WS_BIASP) + (kind ? (size_t)8 * 5 * FF2 : 0) + (size_t)kb * 5 * ldo;
        const int cg = F.tid & 127, ks = F.tid >> 7;
        const int col = cb * 512 + cg * 4;
        float acc[5][4];
#pragma unroll
        for (int r = 0; r < 5; ++r)
#pragma unroll
            for (int q = 0; q < 4; ++q) acc[r][q] = 0.f;
        if (col < N) {
            const float* wp = W + (size_t)(kb * 256 + ks * 64) * N + col;
            for (int k0 = 0; k0 < 64; k0 += 16) {
                f32x4 w[16];
#pragma unroll
                for (int k = 0; k < 16; ++k) w[k] = *(const f32x4*)(wp + (size_t)(k0 + k) * N);
#pragma unroll
                for (int k = 0; k < 16; ++k)
#pragma unroll
                    for (int r = 0; r < 5; ++r) { const float a = cact[r * 256 + ks * 64 + k0 + k]; acc[r][0] += a * w[k][0]; acc[r][1] += a * w[k][1]; acc[r][2] += a * w[k][2]; acc[r][3] += a * w[k][3]; }
            }
        }
#pragma unroll
        for (int r = 0; r < 5; ++r) *(LAS f32x4*)(red + (ks * 5 + r) * 512 + cg * 4) = (f32x4){acc[r][0], acc[r][1], acc[r][2], acc[r][3]};
        __syncthreads();
#pragma unroll
        for (int j = 0; j < 5; ++j) { const int i = F.tid + 512 * j, r = i >> 9, c = i & 511;
            const float sm = (red[(0 * 5 + r) * 512 + c] + red[(1 * 5 + r) * 512 + c]) + (red[(2 * 5 + r) * 512 + c] + red[(3 * 5 + r) * 512 + c]);
            if (cb * 512 + c < N) PB[r * ldo + cb * 512 + c] = sm; }
    }
    __syncthreads();
}
DI void phase_bias_reduce(Frame& F) {
    const float* P2 = WSP(float, WS_BIASP); const float* P1 = P2 + (size_t)8 * 5 * FF2;
    for (int i = F.bid * 512 + F.tid; i < 5 * FF2 + 5 * IN1P; i += F.G * 512) {
        if (i < 5 * FF2) { float sm = 0.f;
#pragma unroll
            for (int kb = 0; kb < 8; ++kb) sm += P2[(size_t)kb * 5 * FF2 + i];
            WSP(float, WS_BIAS2)[i] = sm; }
        else { const int j = i - 5 * FF2, c = j % IN1P; float sm = 0.f;
            if (c < IN1) {
#pragma unroll
                for (int kb = 0; kb < 8; ++kb) sm += P1[(size_t)kb * 5 * IN1P + j]; }
            WSP(float, WS_BIAS1)[j] = sm; }
    }
}

DI void phase_conv(Frame& F) {
    const bf16_t* P = WSP(bf16_t, A_PROJ);
    const int gw = F.bid * 8 + F.wave, NGW = F.G * 8;
    for (int u = gw; u < (NT / 16) * 4; u += NGW) {
        const int run = u >> 2, part = u & 3, isb = part >> 1, half = part & 1;
        const int R0 = run * 16;
        int seq0, seqlen; if (R0 < NL) { seq0 = R0 & ~8191; seqlen = T; } else { seq0 = NL + ((R0 - NL) & ~255); seqlen = TC; }
        const int t0 = R0 - seq0;
        const int ch = half * 512 + F.lane * 8;
        const int pcol = (isb ? 2048 : 0) + ch;
        const float* cw = F.in[isb ? I0_BCW : I0_ACW]; const float* cb = F.in[isb ? I0_BCB : I0_ACB];
        float w0[8], w1[8], w2[8], w3[8], bb[8];
#pragma unroll
        for (int q = 0; q < 8; ++q) { w0[q] = cw[ch + q]; w1[q] = cw[1024 + ch + q]; w2[q] = cw[2048 + ch + q]; w3[q] = cw[3072 + ch + q]; bb[q] = cb[ch + q]; }
        float xm2[8], xm1[8], x0[8], xp1[8];
#define CONV_LD(t_, f_) do { const int _t = (t_); if (_t < 0 || _t >= seqlen) { _Pragma("unroll") for (int q = 0; q < 8; ++q) f_[q] = 0.f; } \
            else { const u32x4 _w = *(const u32x4*)(P + (size_t)(seq0 + _t) * IN0 + pcol); unpack8(_w, f_); } } while (0)
        CONV_LD(t0 - 2, xm2); CONV_LD(t0 - 1, xm1); CONV_LD(t0, x0);
        bf16_t* O = isb ? WSP(bf16_t, A_XCB) : WSP(bf16_t, A_XCA);
        for (int i = 0; i < 16; ++i) {
            CONV_LD(t0 + i + 1, xp1);
            float y[8];
#pragma unroll
            for (int q = 0; q < 8; ++q) { float v = bb[q] + w0[q] * xm2[q] + w1[q] * xm1[q] + w2[q] * x0[q] + w3[q] * xp1[q]; y[q] = isb ? siluf_(v) : v; }
            *(u32x4*)(O + (size_t)(R0 + i) * 1024 + ch) = pack8(y);
#pragma unroll
            for (int q = 0; q < 8; ++q) { xm2[q] = xm1[q]; xm1[q] = x0[q]; x0[q] = xp1[q]; }
        }
#undef CONV_LD
    }
}

constexpr int RG_SEG = 32, RG_SEGLEN = NSTEP / RG_SEG;
template <int PASS> DI void rg_pass(Frame& F) {
    const int gt = F.bid * 512 + F.tid, GT = F.G * 512;
    float* SEGP = WSP(float, A_SEG); float* SEGH = SEGP + 8 * RG_SEG * 1024;
    for (int item = gt; item < 2 * 4 * RG_SEG * 512; item += GT) {
        const int cp = item & 511, seg = (item >> 9) & (RG_SEG - 1), b = (item >> 14) & 3, d = item >> 16, c = cp * 2;
        const bf16_t* RG = WSP(bf16_t, A_RG) + (size_t)d * NT * 1024; const bf16_t* IX = WSP(bf16_t, A_IX) + (size_t)d * NT * 1024;
        bf16_t* HA = WSP(bf16_t, A_HA) + (size_t)d * NT * 1024;
        const float sp0 = log1pf(expf(-F.in[I0_ALAM][d * 1024 + c])), sp1 = log1pf(expf(-F.in[I0_ALAM][d * 1024 + c + 1]));
        float h0 = 0.f, h1 = 0.f, p0 = 1.f, p1 = 1.f;
        const size_t sbase = (size_t)((d * 4 + b) * RG_SEG) * 1024 + c;
        if (PASS == 2) {
            for (int s2 = 0; s2 < seg; ++s2) { const f32x2 pp = *(const f32x2*)(SEGP + sbase + (size_t)s2 * 1024), hh = *(const f32x2*)(SEGH + sbase + (size_t)s2 * 1024); h0 = pp.x * h0 + hh.x; h1 = pp.y * h1 + hh.y; }
        }
        for (int j0 = seg * RG_SEGLEN; j0 < (seg + 1) * RG_SEGLEN; j0 += 12) {
            unsigned r[12], x[12]; int rows[12];
#pragma unroll
            for (int q = 0; q < 12; ++q) { rows[q] = chain_row(d, b, j0 + q); r[q] = *(const unsigned*)(RG + (size_t)rows[q] * 1024 + c); x[q] = *(const unsigned*)(IX + (size_t)rows[q] * 1024 + c); }
#pragma unroll
            for (int q = 0; q < 12; ++q) {
                const float la0 = -8.f * bf2f(r[q] & 0xffffu) * sp0, la1 = -8.f * bf2f(r[q] >> 16) * sp1;
                const float a0 = __expf(la0), a1 = __expf(la1);
                const float b0 = __builtin_amdgcn_sqrtf(fmaxf(1.f - a0 * a0, 0.f)) * bf2f(x[q] & 0xffffu), b1 = __builtin_amdgcn_sqrtf(fmaxf(1.f - a1 * a1, 0.f)) * bf2f(x[q] >> 16);
                h0 = a0 * h0 + b0; h1 = a1 * h1 + b1;
                if (PASS == 1) { p0 *= a0; p1 *= a1; }
                else *(unsigned*)(HA + (size_t)rows[q] * 1024 + c) = cvt_pk_bf16(h0, h1);
            }
        }
        if (PASS == 1) { *(f32x2*)(SEGP + sbase + (size_t)seg * 1024) = (f32x2){p0, p1}; *(f32x2*)(SEGH + sbase + (size_t)seg * 1024) = (f32x2){h0, h1}; }
    }
}

template <int KIND> struct CK {
    static constexpr int DK = KIND == 0 ? 256 : 128;
    static constexpr int DVT = KIND == 0 ? 17 : 16;
    static constexpr int DVP = DVT * 16;
    static constexpr int QLD = DK + 8;
    static constexpr int VLD = DVP + 8;
    static constexpr size_t SLOT = (size_t)DVP * DK;
    static constexpr int IMG = KIND == 0 ? 1024 : 44032;
};
constexpr int TLD = 72;
constexpr int NCHUNK = NSTEP / 64;
struct ChunkLds {
    static constexpr int ROWS = 0, AF = 256, LIF = 512, BA2 = 1024  , W2 = 2048  , TAB = 10240  ;
};
template <int KIND> DI const bf16_t* src_q(Frame& F, int row, int h) { return KIND == 0 ? WSP(bf16_t, A_Q0) + (size_t)row * 1024 + h * 256 : WSP(bf16_t, A_PROJ) + (size_t)row * IN1P + 512 + h * 128; }
template <int KIND> DI const bf16_t* src_k(Frame& F, int row, int h) { return KIND == 0 ? WSP(bf16_t, A_K0) + (size_t)row * 1024 + h * 256 : WSP(bf16_t, A_PROJ) + (size_t)row * IN1P + 1024 + h * 128; }
template <int KIND> DI const bf16_t* src_v(Frame& F, int row, int h) { return KIND == 0 ? WSP(bf16_t, A_V0) + (size_t)row * 1024 + h * 256 : WSP(bf16_t, A_PROJ) + (size_t)row * IN1P + 1536 + h * 256; }
DI void gla_bcum8(Frame& F, int cg, const float (&alr)[16], float (&bc)[8]) {
    const LAS float* w2 = (const LAS float*)(F.lds + ChunkLds::W2) + cg * 8; const LAS float* ba = (const LAS float*)(F.lds + ChunkLds::BA2) + cg * 8;
#pragma unroll
    for (int i0 = 0; i0 < 8; i0 += 4) {
#pragma unroll
        for (int i = i0; i < i0 + 4; ++i) { float z = ba[i];
#pragma unroll
            for (int r = 0; r < 16; ++r) z += alr[r] * w2[r * 128 + i];
            bc[i] = wave_scan(log_sigmoidf_(z) * (1.f / 16.f), F.lane); }
        asm volatile("" : "+v"(bc[i0]), "+v"(bc[i0 + 1]), "+v"(bc[i0 + 2]), "+v"(bc[i0 + 3]));
    }
}
DI void gla_stage_w2(Frame& F, int d, int h) {
    const float* wa2 = F.in[I1_WA2] + (size_t)d * 16 * 512 + h * 128;
    const int r = F.tid >> 5, c4 = (F.tid & 31) * 4;
    *(LAS f32x4*)((LAS float*)(F.lds + ChunkLds::W2) + r * 128 + c4) = *(const f32x4*)(wa2 + r * 512 + c4);
    if (F.tid < 32) *(LAS f32x4*)((LAS float*)(F.lds + ChunkLds::BA2) + c4) = *(const f32x4*)(F.in[I1_BA2] + d * 512 + h * 128 + c4);
}
DI void load_alr(Frame& F, int row, int d, float (&alr)[16]) {
    const bf16_t* p = WSP(bf16_t, A_PROJ) + (size_t)row * IN1P + 3584 + d * 16; float t0[8], t1[8]; unpack8(*(const u32x4*)p, t0); unpack8(*(const u32x4*)(p + 8), t1);
#pragma unroll
    for (int q = 0; q < 8; ++q) { alr[q] = t0[q]; alr[8 + q] = t1[q]; }
}
typedef short s16x4v __attribute__((ext_vector_type(4)));
DI bf16x8 tr_frag(const LAS bf16_t* img, int ld, int s0, int c0, int lane) {
    const int i = lane & 15; const LAS bf16_t* p = img + (s0 + (i >> 2)) * ld + c0 + 4 * (i & 3);
    const s16x4v lo = __builtin_amdgcn_ds_read_tr16_b64_v4i16((LAS s16x4v*)p), hi = __builtin_amdgcn_ds_read_tr16_b64_v4i16((LAS s16x4v*)(p + 4 * ld));
    return __builtin_shufflevector(lo, hi, 0, 1, 2, 3, 4, 5, 6, 7);
}
constexpr int GTAB_LD = 132;
template <int KIND> DI void chunk_k1(Frame& F, bf16_t* STb, float* GAM, int unit, bool first) {
    typedef CK<KIND> C; constexpr int DK = C::DK, QLD = C::QLD, VLD = C::VLD, NMT = DK / 128, KP = DK / 8  , NKI = 64 * KP / 512, NVI = 64 * 32 / 512;
    const int chain = unit / NCHUNK, c = unit % NCHUNK, d = chain >> 4, b = (chain >> 2) & 3, h = chain & 3;
    const int row = chain_row(d, b, c * 64 + F.lane);
    LAS bf16_t* KS = (LAS bf16_t*)(F.lds + C::IMG); LAS bf16_t* VS = KS + 64 * QLD; LAS float* TAB = (LAS float*)(F.lds + ChunkLds::TAB);
    __syncthreads();
    u32x4 kw[NKI], vw[NVI];
#pragma unroll
    for (int it = 0; it < NKI; ++it) { const int idx = F.tid + 512 * it, sidx = idx / KP, pc = idx % KP; kw[it] = *(const u32x4*)(src_k<KIND>(F, chain_row(d, b, c * 64 + sidx), h) + pc * 8); }
#pragma unroll
    for (int it = 0; it < NVI; ++it) { const int idx = F.tid + 512 * it, sidx = idx >> 5, pc = idx & 31; vw[it] = *(const u32x4*)(src_v<KIND>(F, chain_row(d, b, c * 64 + sidx), h) + pc * 8); }
    if (KIND == 0) {
        const float* gt = WSP(float, WS_GATES) + (size_t)row * 16 + d * 8;
        const float li = gt[h], a = wave_scan(log_sigmoidf_(gt[4 + h]), F.lane); const float a63 = __shfl(a, 63);
        const float wsc = __expf(a63 - a + li);
#pragma unroll
        for (int it = 0; it < NKI; ++it) { const int idx = F.tid + 512 * it, sidx = idx / KP, pc = idx % KP; const float w = __shfl(wsc, sidx); float v[8]; unpack8(kw[it], v);
#pragma unroll
            for (int i = 0; i < 8; ++i) v[i] *= w;
            *(LAS u32x4*)(KS + sidx * QLD + pc * 8) = pack8(v); }
        if (F.tid == 0) GAM[unit] = __expf(a63);
        if (F.tid < 64) { LAS u32x4* o = (LAS u32x4*)(VS + F.tid * VLD + 256); o[0] = (u32x4){0x3F80u, 0u, 0u, 0u}; o[1] = (u32x4){0u, 0u, 0u, 0u}; }
    } else {
        float alr[16]; load_alr(F, row, d, alr); if (first || c == 0) { gla_stage_w2(F, d, h); __syncthreads(); }
#pragma unroll
        for (int j = 0; j < 2; ++j) { const int cg = F.wave + 8 * j; float bc[8]; gla_bcum8(F, cg, alr, bc); float e[8];
#pragma unroll
            for (int i = 0; i < 8; ++i) { const float b63 = __shfl(bc[i], 63); e[i] = __expf(b63 - bc[i]); if (F.lane == 0) GAM[(size_t)unit * 128 + cg * 8 + i] = __expf(b63); }
            *(LAS f32x4*)(TAB + F.lane * GTAB_LD + cg * 8) = (f32x4){e[0], e[1], e[2], e[3]}; *(LAS f32x4*)(TAB + F.lane * GTAB_LD + cg * 8 + 4) = (f32x4){e[4], e[5], e[6], e[7]}; }
        __syncthreads();
#pragma unroll
        for (int it = 0; it < NKI; ++it) { const int idx = F.tid + 512 * it, sidx = idx / KP, pc = idx % KP; float v[8]; unpack8(kw[it], v);
            const f32x4 e0 = *(const LAS f32x4*)(TAB + sidx * GTAB_LD + pc * 8), e1 = *(const LAS f32x4*)(TAB + sidx * GTAB_LD + pc * 8 + 4);
#pragma unroll
            for (int i = 0; i < 4; ++i) { v[i] *= e0[i]; v[4 + i] *= e1[i]; }
            *(LAS u32x4*)(KS + sidx * QLD + pc * 8) = pack8(v); }
    }
#pragma unroll
    for (int it = 0; it < NVI; ++it) { const int idx = F.tid + 512 * it, sidx = idx >> 5, pc = idx & 31; *(LAS u32x4*)(VS + sidx * VLD + pc * 8) = vw[it]; }
    __syncthreads();
    const int fr = F.lane & 15, fq = F.lane >> 4;
    bf16_t* slot = STb + (size_t)unit * C::SLOT;
    bf16x8 a[NMT][2];
#pragma unroll
    for (int mi = 0; mi < NMT; ++mi)
#pragma unroll
        for (int ks = 0; ks < 2; ++ks) a[mi][ks] = tr_frag(KS, QLD, ks * 32 + 8 * fq, (F.wave + 8 * mi) * 16, F.lane);
#pragma unroll 4
    for (int nt = 0; nt < C::DVT; ++nt) {
        bf16x8 bb[2];
#pragma unroll
        for (int ks = 0; ks < 2; ++ks) bb[ks] = tr_frag(VS, VLD, ks * 32 + 8 * fq, nt * 16, F.lane);
#pragma unroll
        for (int mi = 0; mi < NMT; ++mi) {
            f32x4 acc = (f32x4){0.f, 0.f, 0.f, 0.f};
#pragma unroll
            for (int ks = 0; ks < 2; ++ks) acc = __builtin_amdgcn_mfma_f32_16x16x32_bf16(a[mi][ks], bb[ks], acc, 0, 0, 0);
            u32x2 w; w.x = cvt_pk_bf16(acc[0], acc[1]); w.y = cvt_pk_bf16(acc[2], acc[3]);
            *(u32x2*)(slot + (size_t)(nt * 16 + fr) * DK + (F.wave + 8 * mi) * 16 + 4 * fq) = w;
        }
    }
}
template <int KIND, int NCH = NCHUNK, int UBP = 0> DI void chunk_k2(Frame& F, bf16_t* STb, const float* GAM) {
    typedef CK<KIND> C; constexpr int DK = C::DK; constexpr int PER = (int)(C::SLOT / 8);
    const int gt = F.bid * 512 + F.tid, GT = F.G * 512;
    for (int item = gt; item < 32 * PER; item += GT) {
        const int chain = item / PER, e = item % PER, k0 = (e * 8) % DK;
        float S[8];
#pragma unroll
        for (int i = 0; i < 8; ++i) S[i] = 0.f;
        bf16_t* p = STb + (size_t)chain * NCH * C::SLOT + (size_t)e * 8;
        constexpr int UB = UBP ? UBP : (KIND == 0 ? 12 : 6); static_assert(NCH % UB == 0, "whole batches");
        for (int c0 = 0; c0 < NCH; c0 += UB) {
            u32x4 dv[UB]; float g[UB][KIND == 0 ? 1 : 8];
#pragma unroll
            for (int q = 0; q < UB; ++q) { dv[q] = *(const u32x4*)(p + (size_t)(c0 + q) * C::SLOT);
                if (KIND == 0) g[q][0] = GAM[chain * NCH + c0 + q];
                else { const float* gp = GAM + ((size_t)(chain * NCH + c0 + q)) * 128 + k0; const f32x4 g0 = *(const f32x4*)gp, g1 = *(const f32x4*)(gp + 4);
                    g[q][0] = g0[0]; g[q][1] = g0[1]; g[q][2] = g0[2]; g[q][3] = g0[3]; g[q][4] = g1[0]; g[q][5] = g1[1]; g[q][6] = g1[2]; g[q][7] = g1[3]; } }
#pragma unroll
            for (int q = 0; q < UB; ++q) {
                float dl[8]; unpack8(dv[q], dl);
                *(u32x4*)(p + (size_t)(c0 + q) * C::SLOT) = pack8(S);
#pragma unroll
                for (int i = 0; i < 8; ++i) S[i] = g[q][KIND == 0 ? 0 : i] * S[i] + dl[i];
            }
        }
    }
}
template <int KIND> DI void chunk_k3(Frame& F, const bf16_t* STb, bf16_t* OUT, int unit, bool first) {
    typedef CK<KIND> C; constexpr int DK = C::DK, QLD = C::QLD, VLD = C::VLD, NKS = DK / 32, KP = DK / 8, NKI = 64 * KP / 512, NVI = 64 * 32 / 512;
    static_assert(C::IMG + (2 * 64 * QLD + 64 * VLD + 64 * TLD) * 2 <= RING_BYTES, "chunk images fit the ring");
    const int chain = unit / NCHUNK, c = unit % NCHUNK, d = chain >> 4, b = (chain >> 2) & 3, h = chain & 3;
    const int row = chain_row(d, b, c * 64 + F.lane);
    LAS int* rows = (LAS int*)(F.lds + ChunkLds::ROWS); LAS float* af = (LAS float*)(F.lds + ChunkLds::AF); LAS float* lif = (LAS float*)(F.lds + ChunkLds::LIF); LAS float* TAB = (LAS float*)(F.lds + ChunkLds::TAB);
    LAS bf16_t* QS = (LAS bf16_t*)(F.lds + C::IMG); LAS bf16_t* KS = QS + 64 * QLD; LAS bf16_t* VS = KS + 64 * QLD; LAS bf16_t* PS = VS + 64 * VLD;
    __syncthreads();
    const int fr = F.lane & 15, fq = F.lane >> 4;
    const bf16_t* slot = STb + (size_t)unit * C::SLOT;
    bf16x8 sb[2][NKS], sn[NKS];
#pragma unroll
    for (int j = 0; j < 2; ++j)
#pragma unroll
        for (int ks = 0; ks < NKS; ++ks) sb[j][ks] = *(const bf16x8*)(slot + (size_t)((F.wave + 8 * j) * 16 + fr) * DK + ks * 32 + fq * 8);
    if (KIND == 0) {
#pragma unroll
        for (int ks = 0; ks < NKS; ++ks) { sn[ks] = (bf16x8){0, 0, 0, 0, 0, 0, 0, 0}; if (fr == 0) sn[ks] = *(const bf16x8*)(slot + (size_t)256 * DK + ks * 32 + fq * 8); }
    }
    {
        u32x4 qw[NKI], kw[NKI], vw[NVI];
#pragma unroll
        for (int it = 0; it < NKI; ++it) { const int idx = F.tid + 512 * it, sidx = idx / KP, pc = idx % KP; const int rw = chain_row(d, b, c * 64 + sidx);
            qw[it] = *(const u32x4*)(src_q<KIND>(F, rw, h) + pc * 8); kw[it] = *(const u32x4*)(src_k<KIND>(F, rw, h) + pc * 8); }
#pragma unroll
        for (int it = 0; it < NVI; ++it) { const int idx = F.tid + 512 * it, sidx = idx >> 5, pc = idx & 31; vw[it] = *(const u32x4*)(src_v<KIND>(F, chain_row(d, b, c * 64 + sidx), h) + pc * 8); }
        if (KIND == 0) {
            if (F.wave == 0) { const float* gt = WSP(float, WS_GATES) + (size_t)row * 16 + d * 8; lif[F.lane] = gt[h]; af[F.lane] = wave_scan(log_sigmoidf_(gt[4 + h]), F.lane); rows[F.lane] = row; }
            if (F.tid < 64) { LAS u32x4* o = (LAS u32x4*)(VS + F.tid * VLD + 256); o[0] = (u32x4){0x3F80u, 0u, 0u, 0u}; o[1] = (u32x4){0u, 0u, 0u, 0u}; }
        } else {
            if (F.wave == 0) rows[F.lane] = row;
            float alr[16]; load_alr(F, row, d, alr); if (first || c == 0) { gla_stage_w2(F, d, h); __syncthreads(); }
#pragma unroll
            for (int j = 0; j < 2; ++j) { const int cg = F.wave + 8 * j; float bc[8]; gla_bcum8(F, cg, alr, bc);
                *(LAS f32x4*)(TAB + F.lane * GTAB_LD + cg * 8) = (f32x4){bc[0], bc[1], bc[2], bc[3]}; *(LAS f32x4*)(TAB + F.lane * GTAB_LD + cg * 8 + 4) = (f32x4){bc[4], bc[5], bc[6], bc[7]}; }
            __syncthreads();
#pragma unroll
            for (int it = 0; it < NKI; ++it) { const int idx = F.tid + 512 * it, sidx = idx / KP, pc = idx % KP; float q[8], k[8]; unpack8(qw[it], q); unpack8(kw[it], k);
                const f32x4 b0 = *(const LAS f32x4*)(TAB + sidx * GTAB_LD + pc * 8), b1 = *(const LAS f32x4*)(TAB + sidx * GTAB_LD + pc * 8 + 4);
#pragma unroll
                for (int i = 0; i < 4; ++i) { q[i] *= __expf(b0[i]) * 0.08838834764831845f; k[i] *= __expf(-b0[i]); q[4 + i] *= __expf(b1[i]) * 0.08838834764831845f; k[4 + i] *= __expf(-b1[i]); }
                qw[it] = pack8(q); kw[it] = pack8(k); }
        }
#pragma unroll
        for (int it = 0; it < NKI; ++it) { const int idx = F.tid + 512 * it, sidx = idx / KP, pc = idx % KP; *(LAS u32x4*)(QS + sidx * QLD + pc * 8) = qw[it]; *(LAS u32x4*)(KS + sidx * QLD + pc * 8) = kw[it]; }
#pragma unroll
        for (int it = 0; it < NVI; ++it) { const int idx = F.tid + 512 * it, sidx = idx >> 5, pc = idx & 31; *(LAS u32x4*)(VS + sidx * VLD + pc * 8) = vw[it]; }
        for (int i = F.tid; i < 64 * TLD / 2; i += 512) ((LAS unsigned*)PS)[i] = 0u;
    }
    __syncthreads();
    {
        for (int tl = F.wave; tl < 10; tl += 8) {
            int ti = 0, si = tl; while (si > ti) { si -= ti + 1; ++ti; }
            f32x4 acc = (f32x4){0.f, 0.f, 0.f, 0.f};
#pragma unroll
            for (int ks = 0; ks < NKS; ++ks) { const bf16x8 a = *(const LAS bf16x8*)(KS + (si * 16 + fr) * QLD + ks * 32 + fq * 8), bb = *(const LAS bf16x8*)(QS + (ti * 16 + fr) * QLD + ks * 32 + fq * 8);
                acc = __builtin_amdgcn_mfma_f32_16x16x32_bf16(a, bb, acc, 0, 0, 0); }
            const int t = ti * 16 + fr; float o[4];
#pragma unroll
            for (int r = 0; r < 4; ++r) { const int sidx = si * 16 + 4 * fq + r; float v = acc[r];
                if (KIND == 0) v *= __expf(af[t] - af[sidx] + lif[sidx]);
                o[r] = sidx <= t ? v : 0.f; }
            u32x2 w; w.x = cvt_pk_bf16(o[0], o[1]); w.y = cvt_pk_bf16(o[2], o[3]);
            *(LAS u32x2*)(PS + t * TLD + si * 16 + 4 * fq) = w;
        }
    }
    __syncthreads();
    {
        bf16x8 vb[2][2];
#pragma unroll
        for (int j = 0; j < 2; ++j)
#pragma unroll
            for (int ks = 0; ks < 2; ++ks) vb[j][ks] = tr_frag(VS, VLD, ks * 32 + 8 * fq, (F.wave + 8 * j) * 16, F.lane);
#pragma unroll 1
        for (int ti = 0; ti < 4; ++ti) {
            bf16x8 pa[2], qa[NKS];
#pragma unroll
            for (int ks = 0; ks < 2; ++ks) pa[ks] = *(const LAS bf16x8*)(PS + (ti * 16 + fr) * TLD + ks * 32 + fq * 8);
#pragma unroll
            for (int ks = 0; ks < NKS; ++ks) qa[ks] = *(const LAS bf16x8*)(QS + (ti * 16 + fr) * QLD + ks * 32 + fq * 8);
            float wt[4], rden[4]; int orow[4];
#pragma unroll
            for (int r = 0; r < 4; ++r) { const int t = ti * 16 + 4 * fq + r; wt[r] = KIND == 0 ? __expf(af[t]) : 1.f; orow[r] = rows[t]; rden[r] = 1.f; }
            if (KIND == 0) {
                f32x4 aP = (f32x4){0.f, 0.f, 0.f, 0.f}, aQ = (f32x4){0.f, 0.f, 0.f, 0.f};
#pragma unroll
                for (int ks = 0; ks < 2; ++ks) { const bf16x8 bb = tr_frag(VS, VLD, ks * 32 + 8 * fq, 256, F.lane); aP = __builtin_amdgcn_mfma_f32_16x16x32_bf16(pa[ks], bb, aP, 0, 0, 0); }
#pragma unroll
                for (int ks = 0; ks < NKS; ++ks) aQ = __builtin_amdgcn_mfma_f32_16x16x32_bf16(qa[ks], sn[ks], aQ, 0, 0, 0);
#pragma unroll
                for (int r = 0; r < 4; ++r) { const float den = aP[r] + wt[r] * aQ[r]; const float dd = __shfl(den, F.lane & 48); rden[r] = 1.f / fmaxf(fabsf(dd), 1.f); }
            }
#pragma unroll
            for (int j = 0; j < 2; ++j) {
                f32x4 aP = (f32x4){0.f, 0.f, 0.f, 0.f}, aQ = (f32x4){0.f, 0.f, 0.f, 0.f};
#pragma unroll
                for (int ks = 0; ks < 2; ++ks) aP = __builtin_amdgcn_mfma_f32_16x16x32_bf16(pa[ks], vb[j][ks], aP, 0, 0, 0);
#pragma unroll
                for (int ks = 0; ks < NKS; ++ks) aQ = __builtin_amdgcn_mfma_f32_16x16x32_bf16(qa[ks], sb[j][ks], aQ, 0, 0, 0);
                const int col = h * 256 + (F.wave + 8 * j) * 16 + fr;
#pragma unroll
                for (int r = 0; r < 4; ++r) {
                    const float o = (aP[r] + wt[r] * aQ[r]) * rden[r];
                    if (KIND == 0) OUT[(size_t)orow[r] * 1024 + col] = f2bf(o);
                    else if (orow[r] < NL) OUT[(size_t)orow[r] * 1024 + col] = f2bf(o);
                }
            }
        }
    }
}
DI void unit_range(Frame& F, int& u0, int& u1) { const int n = 32 * NCHUNK; const long a = (long)n * F.bid / F.G, b = (long)n * (F.bid + 1) / F.G; u0 = (int)a; u1 = (int)b; }
template <int KIND> DI void phase_k1(Frame& F) { bf16_t* ST = WSP(bf16_t, A_ST); float* GAM = WSP(float, A_GAM); int u0, u1; unit_range(F, u0, u1); for (int u = u0; u < u1; ++u) chunk_k1<KIND>(F, ST, GAM, u, u == u0); __syncthreads(); }
template <int KIND> DI void phase_k3(Frame& F, bf16_t* OUTB, size_t dir_stride) {
    const bf16_t* ST = WSP(bf16_t, A_ST);
    int u0, u1; unit_range(F, u0, u1);
    for (int u = u0; u < u1; ++u) { const int d = (u / NCHUNK) >> 4; chunk_k3<KIND>(F, ST, OUTB + (size_t)d * dir_stride, u, u == u0); }
    __syncthreads();
}

constexpr int SG = 4, NSUP = NCHUNK / SG;
struct MlLds { static constexpr int ROWS = 0, TOT = 256, AFT = 1024  , LIT = 2048  , IMG = 4096; };
DI void ml_k1(Frame& F, bf16_t* STb, float* GAM, int unit) {
    constexpr int DK = 256, KLD = 128 + 8, VLD = 280;
    const int chain = unit / (2 * NSUP), rem = unit % (2 * NSUP), sg = rem >> 1, kh = rem & 1, d = chain >> 4, b = (chain >> 2) & 3, h = chain & 3;
    LAS bf16_t* KS = (LAS bf16_t*)(F.lds + MlLds::IMG); LAS bf16_t* VS = KS + 64 * KLD;
    float lw[SG], tot[SG];
#pragma unroll
    for (int j = 0; j < SG; ++j) { const int row = chain_row(d, b, (sg * SG + j) * 64 + F.lane); const float* gt = WSP(float, WS_GATES) + (size_t)row * 16 + d * 8;
        const float li = gt[h], a = wave_scan(log_sigmoidf_(gt[4 + h]), F.lane); tot[j] = __shfl(a, 63); lw[j] = tot[j] - a + li; }
    { float tail = 0.f;
#pragma unroll
      for (int j = SG - 1; j >= 0; --j) { lw[j] = __expf(lw[j] + tail); tail += tot[j]; }
      if (kh == 0 && F.tid == 0) GAM[chain * NSUP + sg] = __expf(tail); }
    const int fr = F.lane & 15, fq = F.lane >> 4;
    f32x4 acc[17];
#pragma unroll
    for (int nt = 0; nt < 17; ++nt) acc[nt] = (f32x4){0.f, 0.f, 0.f, 0.f};
#pragma unroll
    for (int j = 0; j < SG; ++j) {
        const int c = sg * SG + j;
        u32x4 kw[2], vw[4];
#pragma unroll
        for (int it = 0; it < 2; ++it) { const int idx = F.tid + 512 * it, sidx = idx >> 4, pc = idx & 15; kw[it] = *(const u32x4*)(src_k<0>(F, chain_row(d, b, c * 64 + sidx), h) + kh * 128 + pc * 8); }
#pragma unroll
        for (int it = 0; it < 4; ++it) { const int idx = F.tid + 512 * it, sidx = idx >> 5, pc = idx & 31; vw[it] = *(const u32x4*)(src_v<0>(F, chain_row(d, b, c * 64 + sidx), h) + pc * 8); }
        __syncthreads();
#pragma unroll
        for (int it = 0; it < 2; ++it) { const int idx = F.tid + 512 * it, sidx = idx >> 4, pc = idx & 15; const float w = __shfl(lw[j], sidx); float v[8]; unpack8(kw[it], v);
#pragma unroll
            for (int i = 0; i < 8; ++i) v[i] *= w;
            *(LAS u32x4*)(KS + sidx * KLD + pc * 8) = pack8(v); }
#pragma unroll
        for (int it = 0; it < 4; ++it) { const int idx = F.tid + 512 * it, sidx = idx >> 5, pc = idx & 31; *(LAS u32x4*)(VS + sidx * VLD + pc * 8) = vw[it]; }
        if (F.tid < 64) { LAS u32x4* o = (LAS u32x4*)(VS + F.tid * VLD + 256); o[0] = (u32x4){0x3F80u, 0u, 0u, 0u}; o[1] = (u32x4){0u, 0u, 0u, 0u}; }
        __syncthreads();
        bf16x8 a[2];
#pragma unroll
        for (int ks = 0; ks < 2; ++ks) a[ks] = tr_frag(KS, KLD, ks * 32 + 8 * fq, F.wave * 16, F.lane);
#pragma unroll
        for (int nt = 0; nt < 17; ++nt) {
#pragma unroll
            for (int ks = 0; ks < 2; ++ks) acc[nt] = __builtin_amdgcn_mfma_f32_16x16x32_bf16(a[ks], tr_frag(VS, VLD, ks * 32 + 8 * fq, nt * 16, F.lane), acc[nt], 0, 0, 0);
        }
    }
    bf16_t* slot = STb + (size_t)(chain * NSUP + sg) * CK<0>::SLOT;
#pragma unroll
    for (int nt = 0; nt < 17; ++nt) { u32x2 w; w.x = cvt_pk_bf16(acc[nt][0], acc[nt][1]); w.y = cvt_pk_bf16(acc[nt][2], acc[nt][3]);
        *(u32x2*)(slot + (size_t)(nt * 16 + fr) * DK + kh * 128 + F.wave * 16 + 4 * fq) = w; }
}
DI void ml_k3(Frame& F, const bf16_t* STb, bf16_t* OUT, int unit) {
    constexpr int DK = 256, QLD = 264, VLD = 280, NKS = 8;
    static_assert(MlLds::IMG + (2 * 64 * QLD + 64 * VLD + 64 * TLD + 16 * QLD) * 2 <= RING_BYTES, "mLSTM chunk images fit the ring");
    const int chain = unit / NCHUNK, c = unit % NCHUNK, sg = c / SG, jq = c % SG, d = chain >> 4, b = (chain >> 2) & 3, h = chain & 3;
    LAS int* rows = (LAS int*)(F.lds + MlLds::ROWS); LAS float* totl = (LAS float*)(F.lds + MlLds::TOT); LAS float* AFT = (LAS float*)(F.lds + MlLds::AFT); LAS float* LIT = (LAS float*)(F.lds + MlLds::LIT);
    LAS bf16_t* QS = (LAS bf16_t*)(F.lds + MlLds::IMG); LAS bf16_t* KS = QS + 64 * QLD; LAS bf16_t* VS = KS + 64 * QLD; LAS bf16_t* PS = VS + 64 * VLD; LAS bf16_t* NS = PS + 64 * TLD;
    __syncthreads();
    const int fr = F.lane & 15, fq = F.lane >> 4;
    const bf16_t* slot = STb + (size_t)(chain * NSUP + sg) * CK<0>::SLOT;
    u32x4 kw[4], vw[4];
#define ML_LOAD_KV(kb_) do { const int _ck = sg * SG + (kb_); _Pragma("unroll") for (int it = 0; it < 4; ++it) { const int idx = F.tid + 512 * it, sidx = idx >> 5, pc = idx & 31; const int rw = chain_row(d, b, _ck * 64 + sidx); \
        kw[it] = *(const u32x4*)(src_k<0>(F, rw, h) + pc * 8); vw[it] = *(const u32x4*)(src_v<0>(F, rw, h) + pc * 8); } } while (0)
    ML_LOAD_KV(0);
    {
        u32x4 qw[4];
#pragma unroll
        for (int it = 0; it < 4; ++it) { const int idx = F.tid + 512 * it, sidx = idx >> 5, pc = idx & 31; qw[it] = *(const u32x4*)(src_q<0>(F, chain_row(d, b, c * 64 + sidx), h) + pc * 8); }
        if (F.wave <= jq) { const int row = chain_row(d, b, (sg * SG + F.wave) * 64 + F.lane); const float* gt = WSP(float, WS_GATES) + (size_t)row * 16 + d * 8;
            const float a = wave_scan(log_sigmoidf_(gt[4 + h]), F.lane); LIT[F.wave * 64 + F.lane] = gt[h]; AFT[F.wave * 64 + F.lane] = a; if (F.lane == 63) totl[F.wave] = a; if (F.wave == jq) rows[F.lane] = row; }
#pragma unroll
        for (int it = 0; it < 4; ++it) { const int idx = F.tid + 512 * it, sidx = idx >> 5, pc = idx & 31; *(LAS u32x4*)(QS + sidx * QLD + pc * 8) = qw[it]; }
        for (int i = F.tid; i < 15 * QLD / 8; i += 512) ((LAS u32x4*)(NS + QLD))[i] = (u32x4){0u, 0u, 0u, 0u};
    }
    f32x4 accP[4][3];
#pragma unroll
    for (int ti = 0; ti < 4; ++ti)
#pragma unroll
        for (int jt = 0; jt < 3; ++jt) accP[ti][jt] = (f32x4){0.f, 0.f, 0.f, 0.f};
    float offq = 0.f, offk = 0.f;
#define ML_STAGE_KV() do { _Pragma("unroll") for (int it = 0; it < 4; ++it) { const int idx = F.tid + 512 * it, sidx = idx >> 5, pc = idx & 31; *(LAS u32x4*)(KS + sidx * QLD + pc * 8) = kw[it]; *(LAS u32x4*)(VS + sidx * VLD + pc * 8) = vw[it]; } \
        if (F.tid < 64) { LAS u32x4* o = (LAS u32x4*)(VS + F.tid * VLD + 256); o[0] = (u32x4){0x3F80u, 0u, 0u, 0u}; o[1] = (u32x4){0u, 0u, 0u, 0u}; } } while (0)
#define ML_P_AND_PV(kb_, DIAG) do { \
        _Pragma("unroll") for (int tq = 0; tq < 2; ++tq) { const int tl = F.wave + 8 * tq, ti = tl >> 2, si = tl & 3; f32x4 acc = (f32x4){0.f, 0.f, 0.f, 0.f}; \
            if (!((DIAG) && si > ti)) { _Pragma("unroll") for (int ks = 0; ks < NKS; ++ks) { const bf16x8 a = *(const LAS bf16x8*)(KS + (si * 16 + fr) * QLD + ks * 32 + fq * 8), bb = *(const LAS bf16x8*)(QS + (ti * 16 + fr) * QLD + ks * 32 + fq * 8); \
                acc = __builtin_amdgcn_mfma_f32_16x16x32_bf16(a, bb, acc, 0, 0, 0); } } \
            const int t = ti * 16 + fr; const float at = offq + AFT[jq * 64 + t]; float o[4]; \
            _Pragma("unroll") for (int r = 0; r < 4; ++r) { const int sidx = si * 16 + 4 * fq + r; const float v = acc[r] * __expf(at - (offk + AFT[(kb_) * 64 + sidx]) + LIT[(kb_) * 64 + sidx]); o[r] = (!(DIAG) || sidx <= t) ? v : 0.f; } \
            u32x2 w; w.x = cvt_pk_bf16(o[0], o[1]); w.y = cvt_pk_bf16(o[2], o[3]); *(LAS u32x2*)(PS + t * TLD + si * 16 + 4 * fq) = w; } \
        __syncthreads(); \
        _Pragma("unroll") for (int ti = 0; ti < 4; ++ti) { bf16x8 pa[2]; \
            _Pragma("unroll") for (int ks = 0; ks < 2; ++ks) pa[ks] = *(const LAS bf16x8*)(PS + (ti * 16 + fr) * TLD + ks * 32 + fq * 8); \
            _Pragma("unroll") for (int jt = 0; jt < 3; ++jt) { const int c0 = jt < 2 ? (F.wave + 8 * jt) * 16 : 256; \
                _Pragma("unroll") for (int ks = 0; ks < 2; ++ks) accP[ti][jt] = __builtin_amdgcn_mfma_f32_16x16x32_bf16(pa[ks], tr_frag(VS, VLD, ks * 32 + 8 * fq, c0, F.lane), accP[ti][jt], 0, 0, 0); } } } while (0)
    for (int kb = 0; kb < jq; ++kb) {
        ML_STAGE_KV();
        __syncthreads();
        if (kb == 0) { for (int i = 0; i < jq; ++i) offq += totl[i]; }
        ML_LOAD_KV(kb + 1);
        ML_P_AND_PV(kb, false);
        offk += totl[kb];
        __syncthreads();
    }
    bf16x8 sb[2][NKS];
#pragma unroll
    for (int j = 0; j < 2; ++j)
#pragma unroll
        for (int ks = 0; ks < NKS; ++ks) sb[j][ks] = *(const bf16x8*)(slot + (size_t)((F.wave + 8 * j) * 16 + fr) * DK + ks * 32 + fq * 8);
    if (F.tid < DK / 8) *(LAS u32x4*)(NS + F.tid * 8) = *(const u32x4*)(slot + (size_t)256 * DK + F.tid * 8);
    ML_STAGE_KV();
    __syncthreads();
    if (jq == 0) offq = 0.f;
    ML_P_AND_PV(jq, true);
    __syncthreads();
#undef ML_LOAD_KV
#undef ML_STAGE_KV
#undef ML_P_AND_PV
#pragma unroll
    for (int ti = 0; ti < 4; ++ti) {
        bf16x8 qa[NKS];
#pragma unroll
        for (int ks = 0; ks < NKS; ++ks) qa[ks] = *(const LAS bf16x8*)(QS + (ti * 16 + fr) * QLD + ks * 32 + fq * 8);
        float wt[4], rden[4]; int orow[4];
#pragma unroll
        for (int r = 0; r < 4; ++r) { const int t = ti * 16 + 4 * fq + r; wt[r] = __expf(offq + AFT[jq * 64 + t]); orow[r] = rows[t]; }
        { f32x4 aQ = (f32x4){0.f, 0.f, 0.f, 0.f};
#pragma unroll
          for (int ks = 0; ks < NKS; ++ks) { const bf16x8 nb = *(const LAS bf16x8*)(NS + fr * QLD + ks * 32 + fq * 8); aQ = __builtin_amdgcn_mfma_f32_16x16x32_bf16(qa[ks], nb, aQ, 0, 0, 0); }
#pragma unroll
          for (int r = 0; r < 4; ++r) { const float den = accP[ti][2][r] + wt[r] * aQ[r]; const float dd = __shfl(den, F.lane & 48); rden[r] = 1.f / fmaxf(fabsf(dd), 1.f); } }
#pragma unroll
        for (int jt = 0; jt < 2; ++jt) {
            f32x4 aQ = (f32x4){0.f, 0.f, 0.f, 0.f};
#pragma unroll
            for (int ks = 0; ks < NKS; ++ks) aQ = __builtin_amdgcn_mfma_f32_16x16x32_bf16(qa[ks], sb[jt][ks], aQ, 0, 0, 0);
            const int col = h * 256 + (F.wave + 8 * jt) * 16 + fr;
#pragma unroll
            for (int r = 0; r < 4; ++r) OUT[(size_t)orow[r] * 1024 + col] = f2bf((accP[ti][jt][r] + wt[r] * aQ[r]) * rden[r]);
        }
    }
}
DI void ml_phase_k1(Frame& F) {
    bf16_t* ST = WSP(bf16_t, A_ST); float* GAM = WSP(float, A_GAM); const int n = 32 * NSUP * 2;
    const int u0 = (int)((long)n * F.bid / F.G), u1 = (int)((long)n * (F.bid + 1) / F.G);
    for (int u = u0; u < u1; ++u) ml_k1(F, ST, GAM, u);
    __syncthreads();
}
DI void ml_phase_k3(Frame& F) {
    const bf16_t* ST = WSP(bf16_t, A_ST); int u0, u1; unit_range(F, u0, u1);
    for (int u = u0; u < u1; ++u) { const int d = (u / NCHUNK) >> 4; ml_k3(F, ST, WSP(bf16_t, A_HB) + (size_t)d * NT * 1024, u); }
    __syncthreads();
}

DI void phase_finish0(Frame& F) {
    const bf16_t* P = WSP(bf16_t, A_PROJ); const bf16_t* HA = WSP(bf16_t, A_HA); const bf16_t* HB = WSP(bf16_t, A_HB); const bf16_t* XCB = WSP(bf16_t, A_XCB);
    bf16_t* Y = WSP(bf16_t, A_Y);
    const int gw = F.bid * 8 + F.wave, NGW = F.G * 8; const int c0 = F.lane * 16;
    float bn[16], bs[16];
#pragma unroll
    for (int q = 0; q < 16; ++q) { bn[q] = F.in[I0_BNORM][c0 + q]; bs[q] = F.in[I0_BSKIP][c0 + q]; }
    for (int row = gw; row < NT; row += NGW) {
#pragma unroll
        for (int hf = 0; hf < 2; ++hf) {
            const int c = c0 + hf * 8;
            float ga[8], h0[8], h1[8], y[8];
            unpack8(*(const u32x4*)(P + (size_t)row * IN0 + 1024 + c), ga);
            unpack8(*(const u32x4*)(HA + (size_t)row * 1024 + c), h0); unpack8(*(const u32x4*)(HA + ((size_t)NT + row) * 1024 + c), h1);
#pragma unroll
            for (int q = 0; q < 8; ++q) y[q] = gelu_tanh(ga[q]) * (h0[q] + h1[q]);
            *(u32x4*)(Y + (size_t)row * D + c) = pack8(y);
        }
        float hz[16], xc[16]; float ss = 0.f;
#pragma unroll
        for (int hf = 0; hf < 2; ++hf) {
            const int c = c0 + hf * 8;
            float z[8], h0[8], h1[8], x8[8];
            unpack8(*(const u32x4*)(P + (size_t)row * IN0 + 3072 + c), z);
            unpack8(*(const u32x4*)(HB + (size_t)row * 1024 + c), h0); unpack8(*(const u32x4*)(HB + ((size_t)NT + row) * 1024 + c), h1);
            unpack8(*(const u32x4*)(XCB + (size_t)row * 1024 + c), x8);
#pragma unroll
            for (int q = 0; q < 8; ++q) { const float v = sigmoidf_(z[q]) * (h0[q] + h1[q]); hz[hf * 8 + q] = v; xc[hf * 8 + q] = x8[q]; ss += v * v; }
        }
        ss += __shfl_xor(ss, 1); ss += __shfl_xor(ss, 2); ss += __shfl_xor(ss, 4); ss += __shfl_xor(ss, 8);
        const float rs = rsqrtf(ss * (1.f / 256.f) + EPS);
#pragma unroll
        for (int hf = 0; hf < 2; ++hf) {
            float y[8];
#pragma unroll
            for (int q = 0; q < 8; ++q) y[q] = hz[hf * 8 + q] * rs * bn[hf * 8 + q] + bs[hf * 8 + q] * xc[hf * 8 + q];
            *(u32x4*)(Y + (size_t)row * D + 1024 + c0 + hf * 8) = pack8(y);
        }
    }
}

DI void phase_finish1(Frame& F) {
    const bf16_t* P = WSP(bf16_t, A_PROJ); const float* YS = WSP(float, A_YS); const bf16_t* O = WSP(bf16_t, A_O);
    float* YSUM = WSP(float, A_YSUM); bf16_t* GY = WSP(bf16_t, A_GY); bf16_t* Y1 = WSP(bf16_t, A_Y);
    const int gw = F.bid * 8 + F.wave, NGW = F.G * 8;
    const int c8 = F.lane * 8, c16 = F.lane * 16;
    float cd[8], dn[16];
#pragma unroll
    for (int q = 0; q < 8; ++q) cd[q] = F.in[I1_CD][c8 + q];
#pragma unroll
    for (int q = 0; q < 16; ++q) dn[q] = F.in[I1_DNORM][c16 + q];
    for (int row = gw; row < NL; row += NGW) {
        { float u[8]; unpack8(*(const u32x4*)(P + (size_t)row * IN1P + c8), u);
          const f32x4 a0 = *(const f32x4*)(YS + (size_t)row * 512 + c8), a1 = *(const f32x4*)(YS + (size_t)row * 512 + c8 + 4);
          const f32x4 b0 = *(const f32x4*)(YS + ((size_t)NL + row) * 512 + c8), b1 = *(const f32x4*)(YS + ((size_t)NL + row) * 512 + c8 + 4);
          float y[8], gy[8];
#pragma unroll
          for (int q = 0; q < 4; ++q) { y[q] = cd[q] * u[q] + a0[q] + b0[q]; y[4 + q] = cd[4 + q] * u[4 + q] + a1[q] + b1[q]; }
#pragma unroll
          for (int q = 0; q < 8; ++q) gy[q] = gelu_tanh(y[q]);
          *(f32x4*)(YSUM + (size_t)row * 512 + c8) = (f32x4){y[0], y[1], y[2], y[3]}; *(f32x4*)(YSUM + (size_t)row * 512 + c8 + 4) = (f32x4){y[4], y[5], y[6], y[7]};
          *(u32x4*)(GY + (size_t)row * 512 + c8) = pack8(gy); }
        float o[16], gg[16]; float ss = 0.f;
#pragma unroll
        for (int hf = 0; hf < 2; ++hf) {
            float o0[8], o1[8], g8[8];
            unpack8(*(const u32x4*)(O + (size_t)row * 1024 + c16 + hf * 8), o0); unpack8(*(const u32x4*)(O + ((size_t)NL + row) * 1024 + c16 + hf * 8), o1);
            unpack8(*(const u32x4*)(P + (size_t)row * IN1P + 2560 + c16 + hf * 8), g8);
#pragma unroll
            for (int q = 0; q < 8; ++q) { const float v = o0[q] + o1[q]; o[hf * 8 + q] = v; gg[hf * 8 + q] = g8[q]; ss += v * v; }
        }
        ss += __shfl_xor(ss, 1); ss += __shfl_xor(ss, 2); ss += __shfl_xor(ss, 4); ss += __shfl_xor(ss, 8);
        const float rs = rsqrtf(ss * (1.f / 256.f) + EPS);
#pragma unroll
        for (int hf = 0; hf < 2; ++hf) {
            float y[8];
#pragma unroll
            for (int q = 0; q < 8; ++q) y[q] = o[hf * 8 + q] * rs * dn[hf * 8 + q] * siluf_(gg[hf * 8 + q]);
            *(u32x4*)(Y1 + (size_t)row * MIX1 + 512 + c16 + hf * 8) = pack8(y);
        }
    }
}

DI void phase_router(Frame& F) {
    LAS float* rt = (LAS float*)F.lds;
    LAS int* cnt = (LAS int*)(F.lds + 65536);
    const float* modl = WSP(float, WS_MOD) + 5 * 12288;
    for (int i = F.tid; i < 8 * 2048; i += 512) { const int e = i >> 11, k = i & 2047; rt[i] = F.in[I1_ROUTER][k * 8 + e]; }
    bf16_t* H = WSP(bf16_t, A_H); int* TOPE = (int*)(F.ws + RT_TOPE); float* TOPW = (float*)(F.ws + RT_TOPW); int* CNT = (int*)(F.ws + RT_CNT);
    for (int blk = F.bid; blk < NL / 128; blk += F.G) {
        if (F.tid < 8) cnt[F.tid] = 0;
        __syncthreads();
        f32x4 vn[8];
        { const f32x4* xr0 = (const f32x4*)(F.out + (size_t)(blk * 128 + F.wave * 16) * D) + F.lane;
#pragma unroll
          for (int j = 0; j < 8; ++j) vn[j] = xr0[64 * j]; }
        for (int rr = 0; rr < 16; ++rr) {
            const int row = blk * 128 + F.wave * 16 + rr; const int bidx = row >> 13;
            f32x4 v[8]; float ss = 0.f;
#pragma unroll
            for (int j = 0; j < 8; ++j) { v[j] = vn[j]; ss += (v[j].x * v[j].x + v[j].y * v[j].y) + (v[j].z * v[j].z + v[j].w * v[j].w); }
            if (rr < 15) { const f32x4* xr1 = (const f32x4*)(F.out + (size_t)(row + 1) * D) + F.lane;
#pragma unroll
                for (int j = 0; j < 8; ++j) vn[j] = xr1[64 * j]; }
            const float rstd = rsqrtf(wave_sum(ss) * (1.f / D) + EPS);
            const f32x4* gp = (const f32x4*)F.in[I1_N2] + F.lane; const f32x4* scp = (const f32x4*)(modl + bidx * 12288 + 8192) + F.lane; const f32x4* shp = (const f32x4*)(modl + bidx * 12288 + 6144) + F.lane;
            u32x2* o8 = (u32x2*)(H + (size_t)row * D) + F.lane; unsigned* o4 = (unsigned*)((unsigned char*)H + (size_t)row * D) + F.lane;
            float lg[8];
#pragma unroll
            for (int e = 0; e < 8; ++e) lg[e] = 0.f;
#pragma unroll
            for (int j = 0; j < 8; ++j) {
                const f32x4 y = v[j] * rstd * gp[64 * j] * (scp[64 * j] + 1.f) + shp[64 * j];
                if (FP8_MOE) o4[64 * j] = pack4_fp8(y.x * S8_H, y.y * S8_H, y.z * S8_H, y.w * S8_H);
                else { u32x2 w; w.x = cvt_pk_bf16(y.x, y.y); w.y = cvt_pk_bf16(y.z, y.w); o8[64 * j] = w; }
#pragma unroll
                for (int e = 0; e < 8; ++e) { const f32x4 r4 = *(const LAS f32x4*)(rt + e * 2048 + (64 * j + F.lane) * 4); lg[e] += (y.x * r4.x + y.y * r4.y) + (y.z * r4.z + y.w * r4.w); }
            }
#pragma unroll
            for (int e = 0; e < 8; ++e) lg[e] = wave_sum(lg[e]);
            if (F.lane == 0) {
                int e0 = 0; float v0 = lg[0];
#pragma unroll
                for (int e = 1; e < 8; ++e) if (lg[e] > v0) { v0 = lg[e]; e0 = e; }
                int e1 = (e0 + 1) & 7; float v1 = -3.0e38f;
#pragma unroll
                for (int e = 0; e < 8; ++e) if (e != e0 && lg[e] > v1) { v1 = lg[e]; e1 = e; }
                float w1 = 1.f / (1.f + expf(v0 - v1)); if (!(w1 >= 0.f && w1 <= 1.f)) w1 = 0.5f; const float w0 = 1.f - w1;
                TOPE[row * 2] = e0; TOPE[row * 2 + 1] = e1; TOPW[row * 2] = w0; TOPW[row * 2 + 1] = w1;
                atomicAdd((int*)&cnt[e0], 1); atomicAdd((int*)&cnt[e1], 1);
            }
        }
        __syncthreads();
        if (F.tid < 8) CNT[blk * 8 + F.tid] = cnt[F.tid];
        __syncthreads();
    }
}
DI void phase_scatter(Frame& F) {
    LAS int* tot = (LAS int*)F.lds;
    LAS int* pre = tot + 8;
    LAS int* posl = pre + 8;
    const int* CNT = (const int*)(F.ws + RT_CNT); const int* TOPE = (const int*)(F.ws + RT_TOPE); int* POS = (int*)(F.ws + RT_POS);
    int* TEXP = (int*)(F.ws + RT_TEXP); int* NTL = (int*)(F.ws + RT_NTILES);
    const bf16_t* H = WSP(bf16_t, A_H); bf16_t* HS = WSP(bf16_t, A_HS);
    for (int blk = F.bid; blk < NL / 128; blk += F.G) {
        __syncthreads();
        { const int e = F.wave; int t = 0, pr = 0;
          for (int bb = F.lane; bb < 256; bb += 64) { const int c = CNT[bb * 8 + e]; t += c; if (bb < blk) pr += c; }
#pragma unroll
          for (int o = 1; o < 64; o <<= 1) { t += __shfl_xor(t, o); pr += __shfl_xor(pr, o); }
          if (F.lane == 0) { tot[e] = t; pre[e] = pr; } }
        __syncthreads();
        int ebase = 0;
        for (int e = 0; e < F.wave; ++e) ebase += (tot[e] + 255) & ~255;
        { const int e = F.wave; int running = ebase + pre[e];
          for (int q = 0; q < 4; ++q) { const int pi = q * 64 + F.lane; const int row = blk * 128 + (pi >> 1), s = pi & 1;
              const bool match = TOPE[row * 2 + s] == e;
              const unsigned long long bal = __ballot(match);
              const int before = __popcll(bal & ((1ull << F.lane) - 1ull));
              if (match) { posl[pi] = running + before; POS[row * 2 + s] = running + before; }
              running += __popcll(bal); } }
        __syncthreads();
        constexpr int RB = FP8_MOE ? D : 2 * D, NJ = RB / 1024;
        for (int p0 = F.wave * 4; p0 < 256; p0 += 32) {
            u32x4 t[4][NJ]; int pos[4];
#pragma unroll
            for (int q = 0; q < 4; ++q) { const int pi = p0 + q; const int row = blk * 128 + (pi >> 1); pos[q] = posl[pi];
                const u32x4* sp = (const u32x4*)((const unsigned char*)H + (size_t)row * RB) + F.lane;
#pragma unroll
                for (int j = 0; j < NJ; ++j) t[q][j] = sp[64 * j]; }
#pragma unroll
            for (int q = 0; q < 4; ++q) { u32x4* dd = (u32x4*)((unsigned char*)HS + (size_t)pos[q] * RB) + F.lane;
#pragma unroll
                for (int j = 0; j < NJ; ++j) dd[64 * j] = t[q][j]; }
        }
        if (blk == 0) {
            int acc = 0, e_of = -1; int ntl = 0;
            for (int e = 0; e < 8; ++e) { const int nt_e = (tot[e] + 255) >> 8; if (e_of < 0 && F.tid >= acc && F.tid < acc + nt_e) e_of = e; acc += nt_e; }
            ntl = acc;
            if (F.tid < 512) TEXP[F.tid] = e_of < 0 ? 0 : e_of;
            if (F.tid == 0) NTL[0] = ntl;
        }
    }
}
DI void phase_final(Frame& F) {
    const bf16_t* YM = WSP(bf16_t, A_YM); const int* POS = (const int*)(F.ws + RT_POS); const float* TOPW = (const float*)(F.ws + RT_TOPW);
    const float* modl = WSP(float, WS_MOD) + 5 * 12288;
    const int gw = F.bid * 8 + F.wave, NGW = F.G * 8;
    for (int row = gw; row < NL; row += NGW) {
        const int bidx = row >> 13; const int p0 = POS[row * 2], p1 = POS[row * 2 + 1]; const float w0 = TOPW[row * 2], w1 = TOPW[row * 2 + 1];
        f32x4* xr = (f32x4*)(F.out + (size_t)row * D) + F.lane;
        const u32x2* y0 = (const u32x2*)(YM + (size_t)p0 * D) + F.lane; const u32x2* y1 = (const u32x2*)(YM + (size_t)p1 * D) + F.lane;
        const f32x4* g2 = (const f32x4*)(modl + bidx * 12288 + 10240) + F.lane;
        f32x4 v[8]; float ss = 0.f;
#pragma unroll
        for (int j = 0; j < 8; ++j) {
            const u32x2 a = y0[64 * j], b = y1[64 * j];
            f32x4 m; m.x = w0 * bf2f(a.x & 0xffffu) + w1 * bf2f(b.x & 0xffffu); m.y = w0 * bf2f(a.x >> 16) + w1 * bf2f(b.x >> 16);
            m.z = w0 * bf2f(a.y & 0xffffu) + w1 * bf2f(b.y & 0xffffu); m.w = w0 * bf2f(a.y >> 16) + w1 * bf2f(b.y >> 16);
            v[j] = xr[64 * j] + g2[64 * j] * m;
            ss += (v[j].x * v[j].x + v[j].y * v[j].y) + (v[j].z * v[j].z + v[j].w * v[j].w);
        }
        const float rstd = rsqrtf(wave_sum(ss) * (1.f / D) + EPS);
        const f32x4* gp = (const f32x4*)F.in[I_FNORM] + F.lane;
#pragma unroll
        for (int j = 0; j < 8; ++j) xr[64 * j] = v[j] * rstd * gp[64 * j];
    }
}

constexpr int NPHASE = 26;
__global__ void __launch_bounds__(512, 2) mega(Params prm) {
    extern __shared__ __attribute__((aligned(16))) unsigned char lds_raw[];
    Frame F;
    F.lds = (LAS unsigned char*)lds_raw;
    F.tid = threadIdx.x; F.lane = F.tid & 63; F.wave = __builtin_amdgcn_readfirstlane(F.tid >> 6);
    F.G = gridDim.x; F.bid = blockIdx.x;
    F.in = prm.in; F.out = prm.out; F.ws = prm.ws;
    volatile LAS unsigned* MISC = (volatile LAS unsigned*)(F.lds + MISC_OFF);
    if (F.tid < 64) MISC[F.tid] = 0u;
    __syncthreads();
    const int lo = prm.lo, hi = prm.hi;
    unsigned* barw = (unsigned*)(F.ws + WS_CTL) + 4096 + prm.li * 4096;
    XcdBarrier bar; bar.bar = barw; bar.x = 0; bar.st = nullptr;
    if (hi - lo > 1) bar = xcd_barrier_post(barw, MISC + 8);
#ifndef PHASE_MASK
#define PHASE_MASK 0xffffffffu
#endif
#define IN(k) (((PHASE_MASK >> (k)) & 1u) && lo <= (k) && (k) < hi)
#define SEAM(k) do { if (IN((k) + 1)) xcd_barrier(bar); asm volatile("" : "+v"(F.tid), "+v"(F.lane)); } while (0)
    LAS unsigned char* ring = F.lds;
    const float* mod0 = WSP(float, WS_MOD); const float* mod1 = WSP(float, WS_MOD) + 5 * 12288;
    float* XCX = WSP(float, WS_XCX);

    if (IN(0)) { phase_prologue(F); SEAM(0); }
    if (IN(1)) { phase_norm(F, F.in[I_X], F.in[I_CTX], F.in[I0_N1], mod0, 0, 2048, WSP(bf16_t, A_H), false, NT); SEAM(1); }
    if (IN(2)) {
        pg8::Gemm g{WSP(bf16_t, A_H), WSP(bf16_t, WT_IN0), D, D, D, 0}; pg8::Sched S = pg8::make_sched(NT / 256, IN0 / 256, F.G, F.bid, D, D);
        pg8::EpiBf16 E{WSP(bf16_t, A_PROJ), IN0, 1.f}; pg8::gemm_phase(ring, g, S, E); tail_convert(F, (NT / 256) * (IN0 / 256), TB_IN0, TQ_IN0); SEAM(2); }
    if (IN(3)) { phase_bias(F); phase_conv(F); SEAM(3); }
    if (IN(4)) {
#ifndef P4_MASK
#define P4_MASK 15
#endif
        if (P4_MASK & 8) { pg8::Gemm g{WSP(bf16_t, A_XCB), WSP(bf16_t, WT_GT), 1024, 1024, 1024, 0}; pg8::Sched S = pg8::make_sched(NT / 256, 1, F.G, F.bid, 1024, 1024);
          pg8::EpiGates E{WSP(float, WS_GATES), F.in[I0_BBIF]}; pg8::gemm_phase(ring, g, S, E); }
        if (P4_MASK & 2) { pg8::Gemm g{WSP(bf16_t, A_XCB), WSP(bf16_t, WT_QK), 1024, 256, 256, 0}; pg8::Sched S = pg8::make_sched(NT / 256, 8, F.G, (F.bid + 96) % F.G, 1024, 256); S.ppb = 2; S.a_blk = 256 * 2;
          pg8::EpiQK E{WSP(bf16_t, A_Q0), WSP(bf16_t, A_K0), 0.0625f}; pg8::gemm_phase(ring, g, S, E); }
        if (P4_MASK & 4) { pg8::Gemm g{WSP(bf16_t, A_PROJ) + 2048, WSP(bf16_t, WT_V), IN0, 256, 256, 0}; pg8::Sched S = pg8::make_sched(NT / 256, 4, F.G, (F.bid + 112) % F.G, IN0, 256); S.ppb = 1; S.a_blk = 256 * 2;
          pg8::EpiBf16 E{WSP(bf16_t, A_V0), 1024, 1.f}; pg8::gemm_phase(ring, g, S, E); }
        if (P4_MASK & 1) { pg8::Gemm g{WSP(bf16_t, A_XCA), WSP(bf16_t, WT_RG), 1024, 128, 128, 0}; pg8::Sched S = pg8::make_sched(NT / 256, 16, F.G, (F.bid + 64) % F.G, 1024, 128); S.ppb = 2; S.a_blk = 128 * 2;
          pg8::EpiRG E{WSP(bf16_t, A_XCA), WSP(bf16_t, A_RG), WSP(bf16_t, A_IX), F.in[I0_ABR], F.in[I0_ABI]}; pg8::gemm_phase(ring, g, S, E); }
        SEAM(4); }
    if (IN(5)) { rg_pass<1>(F); ml_phase_k1(F); SEAM(5); }
    if (IN(6)) { rg_pass<2>(F); chunk_k2<0, NSUP, 11>(F, WSP(bf16_t, A_ST), WSP(float, A_GAM)); SEAM(6); }
    if (IN(7)) { ml_phase_k3(F); SEAM(7); }
    if (IN(8)) { phase_bias_reduce(F); phase_finish0(F); SEAM(8); }
    if (IN(9)) {
        pg8::Gemm g{WSP(bf16_t, A_Y), WSP(bf16_t, WT_OUT0), D, D, D, 0}; pg8::Sched S = pg8::make_sched(NT / 256, D / 256, F.G, F.bid, D, D);
        pg8::EpiResidT<FP8_FFN ? 1 : 2> E{F.in[I_X], F.in[I_CTX], F.in[I0_N2], F.ws, F.out, 0, 4096, 0, 1.f, 0, 8192, 0};
        pg8::gemm_phase(ring, g, S, E); tail_convert(F, (NT / 256) * (D / 256), TB_OUT0, TQ_OUT0); SEAM(9); }
    if (IN(11)) {
        constexpr int E2 = FP8_FFN ? 2 : 1;
        pg8::Gemm g{WSP(bf16_t, A_H), WSP(bf16_t, WT_FWI0), D / E2, D / E2, D / E2, 0}; pg8::Sched S = pg8::make_sched(NT / 256, FF2 / 256, F.G, F.bid, D / E2, D / E2);
        pg8::EpiSwiglu<FP8_FFN != 0> E{WSP(void, A_ACT0), FF2 / 256, FP8_FFN ? 1.f / (S8_H * S8_W1) : 1.f, WSP(float, WS_SSQ), WSP(float, WS_BIAS2), -1, (LAS float*)(F.lds + pg8::RSTD_OFF)}; pg8::gemm_phase<FP8_FFN != 0>(ring, g, S, E); tail_convert(F, (NT / 256) * (FF2 / 256), TB_FWI, TQ_FWI); SEAM(11); }
    if (IN(12)) {
        constexpr int E2 = FP8_FFN ? 2 : 1;
        pg8::Gemm g{WSP(bf16_t, A_ACT0), WSP(bf16_t, WT_FWO0), FF / E2, FF / E2, FF / E2, 0}; pg8::Sched S = pg8::make_sched(NT / 256, D / 256, F.G, F.bid, FF / E2, FF / E2);
        pg8::EpiResidT<2> E{nullptr, nullptr, F.in[I1_N1], F.ws, F.out, 0, 10240, 0, FP8_FFN ? 1.f / (S8_ACT * S8_W2) : 1.f, 1, 2048, 1};
        pg8::gemm_phase<FP8_FFN != 0>(ring, g, S, E); tail_convert(F, (NT / 256) * (D / 256), TB_FWO, TQ_FWO); SEAM(12); }
    if (IN(14)) {
        pg8::Gemm g{WSP(bf16_t, A_H), WSP(bf16_t, WT_IN1), D, D, D, 0}; pg8::Sched S = pg8::make_sched(NT / 256, IN1P / 256, F.G, F.bid, D, D);
        pg8::EpiBf16N E{WSP(bf16_t, A_PROJ), IN1P, WSP(float, WS_SSQ), WSP(float, WS_BIAS1), IN1P, -1, (LAS float*)(F.lds + pg8::RSTD_OFF)}; pg8::gemm_phase(ring, g, S, E); tail_convert(F, (NT / 256) * (IN1P / 256), TB_IN1, TQ_IN1); SEAM(14); }
    if (IN(15)) {
        { pg8::Gemm g{WSP(bf16_t, A_PROJ), WSP(bf16_t, WT_S5W1), IN1P, 256, 256, 1}; pg8::Sched S = pg8::make_sched(S5ROWS / 256, 96, F.G, F.bid, 16 * IN1P, 256); S.ppb = 3; S.a_blk = 16 * 2;
          pg8::EpiS5A E{WSP(bf16_t, A_YI), WSP(float, A_SLOC)}; pg8::gemm_phase<false, pg8::EpiS5A, pg8::Sched, true, true, 1>(ring, g, S, E); }
        phase_k1<1>(F); SEAM(15); }
    if (IN(16)) { phase_s5_carry(F); chunk_k2<1>(F, WSP(bf16_t, A_ST), WSP(float, A_GAM)); SEAM(16); }
    if (IN(17)) {
        { pg8::Gemm g{WSP(bf16_t, A_SIN), WSP(bf16_t, WT_S5W3), 128, 128, 128, 0}; pg8::Sched S = pg8::make_sched(2048 / 256, 64, F.G, F.bid, 128, 128); S.ppb = 1; S.a_blk = (long)S5ROWS * 128 * 2;
          pg8::EpiS5C E{WSP(bf16_t, A_YI), WSP(float, A_YS)}; pg8::gemm_phase(ring, g, S, E); }
        asm volatile("" : "+v"(F.tid), "+v"(F.lane) :: "memory"); }
    if (IN(17)) { phase_k3<1>(F, WSP(bf16_t, A_O), (size_t)NL * 1024); SEAM(17); }
    if (IN(18)) { phase_finish1(F); SEAM(18); }
    if (IN(19)) {
        pg8::Gemm g{WSP(bf16_t, A_GY), WSP(bf16_t, WT_GLU), 512, 512, 512, 0}; pg8::Sched S = pg8::make_sched(NL / 256, 2, F.G, F.bid, 512, 512);
        pg8::EpiGlu E{WSP(float, A_YSUM), F.in[I1_GLUB], WSP(bf16_t, A_Y)}; pg8::gemm_phase(ring, g, S, E); SEAM(19); }
    if (IN(20)) {
        pg8::Gemm g{WSP(bf16_t, A_Y), WSP(bf16_t, WT_OUT1), MIX1, MIX1, MIX1, 0}; pg8::Sched S = pg8::make_sched(NL / 256, D / 256, F.G, F.bid, MIX1, MIX1);
        pg8::EpiResid E{nullptr, nullptr, nullptr, F.ws, F.out, 1, 4096, 1, 1.f, 0, 0, 0}; pg8::gemm_phase(ring, g, S, E); SEAM(20); }
    if (IN(21)) { phase_router(F); SEAM(21); }
    if (IN(22)) { phase_scatter(F); SEAM(22); }
    if (IN(23)) {
        const int ntl = *(const int*)(F.ws + RT_NTILES); constexpr int E2 = FP8_MOE ? 2 : 1;
        pg8::Gemm g{WSP(bf16_t, A_HS), WSP(bf16_t, WT_MWI), D / E2, D / E2, D / E2, 0}; pg8::Sched S = pg8::make_sched(ntl, FF2 / 256, F.G, F.bid, D / E2, D / E2); S.texp = (const int*)(F.ws + RT_TEXP); S.e_tiles = FF2 / 256;
        pg8::EpiSwiglu<FP8_MOE != 0> E{WSP(void, A_ACT1), FF2 / 256, FP8_MOE ? 1.f / (S8_H * S8_W1) : 1.f}; pg8::gemm_phase<FP8_MOE != 0, decltype(E), pg8::Sched, true, FP8_SP2>(ring, g, S, E); SEAM(23); }
    if (IN(24)) {
        const int ntl = *(const int*)(F.ws + RT_NTILES); constexpr int E2 = FP8_MOE ? 2 : 1;
        pg8::Gemm g{WSP(bf16_t, A_ACT1), WSP(bf16_t, WT_MWO), FF / E2, FF / E2, FF / E2, 0}; pg8::Sched S = pg8::make_sched(ntl, D / 256, F.G, F.bid, FF / E2, FF / E2); S.texp = (const int*)(F.ws + RT_TEXP); S.e_tiles = D / 256;
        pg8::EpiBf16 E{WSP(bf16_t, A_YM), D, FP8_MOE ? 1.f / (S8_ACT * S8_W2) : 1.f}; pg8::gemm_phase<FP8_MOE != 0, decltype(E), pg8::Sched, true, FP8_SP2>(ring, g, S, E); SEAM(24); }
    if (IN(25)) { phase_final(F); }
#undef IN
#undef SEAM
}

extern "C" void kernel_launch(void* const* d_in, const int* in_sizes, int n_in, void* d_out, int out_size, void* d_ws, size_t ws_size, hipStream_t stream) {
    static int grid = 0;
    if (grid == 0) {
        if (n_in != N_IN || out_size != NL * D || ws_size < WS_END) { fprintf(stderr, "kernel_launch: unexpected problem (n_in %d, out %d, ws %zu < %zu)\n", n_in, out_size, ws_size, (size_t)WS_END); grid = -1; return; }
        int dev = 0, cus = 0;
        if (hipGetDevice(&dev) != hipSuccess || hipDeviceGetAttribute(&cus, hipDeviceAttributeMultiprocessorCount, dev) != hipSuccess) { grid = -1; return; }
        if (hipFuncSetAttribute((const void*)mega, hipFuncAttributeMaxDynamicSharedMemorySize, LDS_BYTES) != hipSuccess) { fprintf(stderr, "kernel_launch: hipFuncSetAttribute failed\n"); grid = -1; return; }
        int per_cu = 0; (void)hipOccupancyMaxActiveBlocksPerMultiprocessor(&per_cu, (const void*)mega, 512, LDS_BYTES); (void)hipGetLastError();
        if (per_cu < 1) fprintf(stderr, "kernel_launch: occupancy query reports %d blocks per CU\n", per_cu);
        grid = cus;
    }
    if (grid < 0) return;
    (void)hipMemsetAsync((char*)d_ws + WS_CTL, 0, CTL_BYTES, stream);
    Params p{};
    for (int i = 0; i < N_IN; ++i) p.in[i] = (const float*)d_in[i];
    p.out = (float*)d_out; p.ws = (unsigned char*)d_ws;
#if MK_PER_PHASE
    for (int k = 0; k < NPHASE; ++k) { p.lo = k; p.hi = k + 1; p.li = 0; hipLaunchKernelGGL(mega, dim3(grid), dim3(512), LDS_BYTES, stream, p); }
#elif defined(PROBE_A)
    p.lo = 0; p.hi = PROBE_B; p.li = 0; hipLaunchKernelGGL(mega, dim3(grid), dim3(512), LDS_BYTES, stream, p);
    p.lo = PROBE_A; p.hi = PROBE_B; p.li = 1; hipLaunchKernelGGL(mega, dim3(grid), dim3(512), LDS_BYTES, stream, p);
    if (PROBE_B < NPHASE) { p.lo = PROBE_B; p.hi = NPHASE; p.li = 2; hipLaunchKernelGGL(mega, dim3(grid), dim3(512), LDS_BYTES, stream, p); }
#else
    p.lo = 0; p.hi = NPHASE; p.li = 0; hipLaunchKernelGGL(mega, dim3(grid), dim3(512), LDS_BYTES, stream, p);
#endif
}
```

```cpp
#include <hip/hip_runtime.h>
#include <cstdio>
#include <cstdint>

#ifndef MK_PER_PHASE
#define MK_PER_PHASE 0
#endif

#ifndef FP8_MOE
#define FP8_MOE 1
#endif
#ifndef FP8_FFN
#define FP8_FFN 1
#endif
#ifndef FP8_SP2
#define FP8_SP2 true
#endif
#define DI __device__ __forceinline__
#define LAS __attribute__((address_space(3)))
typedef unsigned short bf16_t;
typedef float f32x4 __attribute__((ext_vector_type(4)));
typedef float f32x2 __attribute__((ext_vector_type(2)));
typedef unsigned u32x4 __attribute__((ext_vector_type(4)));
typedef unsigned u32x2 __attribute__((ext_vector_type(2)));
typedef short bf16x8 __attribute__((ext_vector_type(8)));

constexpr int D = 2048, NB = 4, T = 8192, TC = 256;
constexpr int NL = NB * T;
constexpr int NCX = NB * TC;
constexpr int NT = NL + NCX;
constexpr int FF = 5632, FF2 = 11264;
constexpr int IN0 = 4096, IN1 = 3616, IN1P = 3840, MIX1 = 1536;
constexpr int NEXP = 8;
constexpr int MOE_ROWS = 2 * NL + NEXP * 256;
constexpr float EPS = 1e-6f;
constexpr int NSTEP = TC + T;

enum { I_X = 0, I_C, I_CTX, I_CCTX,
       I0_MODW, I0_MODB, I0_N1, I0_N2, I0_WIN, I0_WOUT, I0_ACW, I0_ACB, I0_AWR, I0_ABR, I0_AWI, I0_ABI, I0_ALAM,
       I0_BCW, I0_BCB, I0_BWQ, I0_BWK, I0_BWV, I0_BWIF, I0_BBIF, I0_BNORM, I0_BSKIP, I0_FWI, I0_FWO,
       I1_MODW, I1_MODB, I1_N1, I1_N2, I1_WIN, I1_WOUT, I1_LRE, I1_LIM, I1_LDT, I1_BRE, I1_BIM, I1_CRE, I1_CIM, I1_CD, I1_GLUW, I1_GLUB,
       I1_WA2, I1_BA2, I1_DNORM, I1_ROUTER, I1_MWI, I1_MWO, I_FNORM, N_IN };

constexpr size_t MiB = 1u << 20;
constexpr size_t WS_CTL = 0, CTL_BYTES = 1 * MiB;
constexpr size_t WS_MOD = 1 * MiB;
constexpr size_t WS_S5AB = 2 * MiB;
constexpr size_t WS_S5BB = 2 * MiB + 256 * 1024;
constexpr size_t WS_GATES = 3 * MiB;
constexpr size_t WS_ROUTE = 6 * MiB;
constexpr size_t RT_TOPE = WS_ROUTE, RT_TOPW = WS_ROUTE + 256 * 1024, RT_POS = WS_ROUTE + 512 * 1024, RT_CNT = WS_ROUTE + 768 * 1024, RT_TEXP = RT_CNT + 8192, RT_NTILES = RT_TEXP + 2048;
constexpr size_t WS_XCX = 8 * MiB;
constexpr size_t WS_WT = 16 * MiB;
constexpr size_t WT_IN0 = WS_WT, WT_OUT0 = WT_IN0 + 16 * MiB, WT_FWI0 = WT_OUT0 + 8 * MiB, WT_FWO0 = WT_FWI0 + 44 * MiB,
                 WT_IN1 = WT_FWO0 + 22 * MiB, WT_OUT1 = WT_IN1 + 15 * MiB, WT_MWI = WT_OUT1 + 6 * MiB, WT_MWO = WT_MWI + 352 * MiB,
                 WT_GLU = WT_MWO + 176 * MiB, WT_RG = WT_GLU + 1 * MiB, WT_QK = WT_RG + 1 * MiB, WT_V = WT_QK + 1 * MiB, WT_GT = WT_V + 1 * MiB,
                 WT_S5W1 = WT_GT + 1 * MiB,
                 WT_S5W3 = WT_S5W1 + 12 * MiB,
                 WS_ACTS = WT_S5W3 + 4 * MiB;
constexpr size_t R_H = WS_ACTS;
constexpr size_t R_F = R_H + 132 * MiB;
constexpr size_t R_B = R_F + 132 * MiB;
constexpr size_t R_C = R_B + 264 * MiB;
constexpr size_t R_D = R_C + 396 * MiB;
constexpr size_t R_E = R_D + 198 * MiB;
constexpr size_t A_ST = R_E + 264 * MiB;
constexpr size_t A_GAM = A_ST + 562 * MiB;
constexpr size_t A_SEG = A_GAM + 3 * MiB;
constexpr size_t WS_SSQ = A_SEG + 2 * MiB;
constexpr size_t WS_BIAS2 = WS_SSQ + 5 * MiB;
constexpr size_t WS_BIAS1 = WS_BIAS2 + 512 * 1024;
constexpr size_t WS_BIASP = WS_SSQ + 6 * MiB;
constexpr size_t WS_END = WS_SSQ + 9 * MiB;
constexpr size_t A_H = R_H, A_Y = R_F, A_PROJ = R_B, A_HS = R_B;
constexpr size_t A_XCA = R_C, A_XCB = R_C + 66 * MiB, A_RG = R_C + 132 * MiB, A_IX = R_C + 264 * MiB;
constexpr size_t A_Q0 = R_D, A_K0 = R_D + 66 * MiB, A_V0 = R_D + 132 * MiB;
constexpr size_t A_HA = R_E, A_HB = R_E + 132 * MiB;
constexpr size_t A_ACT0 = R_B;
constexpr size_t A_YS = R_C;
constexpr size_t A_GY = R_D, A_YSUM = R_D + 32 * MiB;
constexpr size_t A_O = R_E;
constexpr int S5ROWS = 2304;
constexpr size_t A_YI = R_H;
constexpr size_t A_SIN = R_H + 72 * MiB;
constexpr size_t A_SLOC = R_F;
constexpr size_t A_ACT1 = R_C;
constexpr size_t A_YM = R_H;
static_assert((size_t)MOE_ROWS * FF * 2 <= (396 + 198 + 264) * MiB, "ACT1 fits");
static_assert((size_t)MOE_ROWS * D * 2 <= 264 * MiB, "YM/HS fit");
static_assert((size_t)NT * FF * 2 <= (264 + 132) * MiB, "ACT0 fits in R_B + XCA|XCB");

constexpr int RING_BYTES = 131072;
constexpr int MISC_OFF = RING_BYTES;
constexpr int LDS_BYTES = 147456;

DI float bf2f(unsigned v) { return __uint_as_float(v << 16); }
typedef __bf16 bf16x2_native __attribute__((ext_vector_type(2)));
DI unsigned cvt_pk_bf16(float lo, float hi) { bf16x2_native v = {(__bf16)lo, (__bf16)hi}; return __builtin_bit_cast(unsigned, v); }
DI unsigned short f2bf(float f) { return (unsigned short)(cvt_pk_bf16(f, 0.f) & 0xffffu); }
constexpr float S8_H = 16.f, S8_W1 = 512.f, S8_ACT = 8.f, S8_W2 = 1024.f;
DI float clamp8(float v) { return fminf(fmaxf(v, -448.f), 448.f); }
DI unsigned pack4_fp8(float a, float b, float c, float d) { unsigned w = 0; w = __builtin_amdgcn_cvt_pk_fp8_f32(clamp8(a), clamp8(b), w, false); w = __builtin_amdgcn_cvt_pk_fp8_f32(clamp8(c), clamp8(d), w, true); return w; }
template <int CTRL, int RMASK, bool BC> DI float dpp_mov(float src) { return __int_as_float(__builtin_amdgcn_update_dpp(0, __float_as_int(src), CTRL, RMASK, 0xf, BC)); }
DI float wave_scan(float v, int = 0) {
    v += dpp_mov<0x111, 0xf, true>(v);
    v += dpp_mov<0x112, 0xf, true>(v);
    v += dpp_mov<0x114, 0xf, true>(v);
    v += dpp_mov<0x118, 0xf, true>(v);
    v += dpp_mov<0x142, 0xa, false>(v);
    v += dpp_mov<0x143, 0xc, false>(v);
    return v;
}
DI float wave_sum(float v) { return __int_as_float(__builtin_amdgcn_readlane(__float_as_int(wave_scan(v)), 63)); }
DI void lds_barrier() { asm volatile("s_waitcnt lgkmcnt(0)" ::: "memory"); __builtin_amdgcn_s_barrier(); asm volatile("" ::: "memory"); }
DI float sigmoidf_(float x) { return __builtin_amdgcn_rcpf(1.f + __expf(-x)); }
DI float siluf_(float x) { return x * __builtin_amdgcn_rcpf(1.f + __expf(-x)); }
DI float gelu_tanh(float x) { const float u = 0.7978845608028654f * (x + 0.044715f * x * x * x); const float e = __expf(2.f * u); const float th = 1.f - 2.f * __builtin_amdgcn_rcpf(e + 1.f); return 0.5f * x * (1.f + th); }
DI float log_sigmoidf_(float x) { return fminf(x, 0.f) - __logf(1.f + __expf(-fabsf(x))); }
DI void unpack8(const u32x4 w, float (&f)[8]) {
    f[0] = bf2f(w.x & 0xffffu); f[1] = bf2f(w.x >> 16); f[2] = bf2f(w.y & 0xffffu); f[3] = bf2f(w.y >> 16);
    f[4] = bf2f(w.z & 0xffffu); f[5] = bf2f(w.z >> 16); f[6] = bf2f(w.w & 0xffffu); f[7] = bf2f(w.w >> 16);
}
DI u32x4 pack8(const float (&f)[8]) { u32x4 w; w.x = cvt_pk_bf16(f[0], f[1]); w.y = cvt_pk_bf16(f[2], f[3]); w.z = cvt_pk_bf16(f[4], f[5]); w.w = cvt_pk_bf16(f[6], f[7]); return w; }
DI int chain_row(int d, int b, int j) {
    if (j < TC) { const int t = d ? (TC - 1 - j) : j; return NL + b * TC + t; }
    const int jj = j - TC; const int t = d ? (T - 1 - jj) : jj; return b * T + t;
}

namespace pg8 {
constexpr int BM = 256, BK = 64, HALF = 128, HTB = HALF * BK * 2, STAGE_BYTES = 8 * HTB, NXCD = 8, WGM = 8;
__host__ __device__ __forceinline__ int lds_byte(int r, int c) { const int st = (r >> 4) * 2 + (c >> 5), rr = r & 15, cc = c & 31, ob = rr * 64 + cc * 2; return st * 1024 + (ob ^ (((ob >> 9) & 1) << 5)); }
__host__ __device__ __forceinline__ void stage_rc(int b, int& R, int& C) { const int st = b / 1024, sb = b % 1024, swz = sb ^ (((sb >> 9) & 1) << 5); R = (st >> 1) * 16 + swz / 64; C = (st & 1) * 32 + (swz % 64) / 2; }
__host__ __device__ __forceinline__ int perm32(int rho) { const int n = rho >> 4, i = rho & 15; return 8 * (i >> 2) + 4 * n + (i & 3); }

struct Unit { int pm, pn; long aoff, boff; int par; };
struct Gemm { const bf16_t* A; const bf16_t* Bt; int lda, ldb, K; int amode; };

struct Sched {
    int nM, nN, G, c;
    long a_tile, b_tile;
    int ppb; long a_blk;
    const int* texp; int e_tiles;
    DI bool next(int i, Unit& u) const {
        const long L = (long)i * G + c; const int nwg = nM * nN; if (L >= nwg) return false;
        int wgid = (int)L; { const int q = nwg / NXCD, r = nwg % NXCD, xcd = wgid % NXCD, off = wgid / NXCD; wgid = (xcd < r ? xcd * (q + 1) : r * (q + 1) + (xcd - r) * q) + off; }
        const int nig = WGM * nN, gid = wgid / nig, fm = gid * WGM, gsz = (nM - fm) < WGM ? (nM - fm) : WGM;
        u.pm = fm + ((wgid % nig) % gsz); u.pn = (wgid % nig) / gsz;
        u.aoff = (long)u.pm * a_tile + (long)(u.pn / ppb) * a_blk;
        const int bt = texp ? (texp[u.pm] * e_tiles + u.pn) : u.pn;
        u.boff = (long)bt * b_tile;
        return true;
    }
    DI void a_ready(const Unit&) const {}
    DI void done(const Unit&) const {}
};
DI Sched make_sched(int nM, int nN, int G, int c, int lda, int ldb) { Sched s; s.nM = nM; s.nN = nN; s.G = G; s.c = c; s.a_tile = (long)256 * lda * 2; s.b_tile = (long)256 * ldb * 2; s.ppb = 1 << 30; s.a_blk = 0; s.texp = nullptr; s.e_tiles = 0; return s; }

template <class T, class = void> struct has_prefetch { static constexpr bool value = false; };
template <class T> struct has_prefetch<T, decltype(void(&T::prefetch))> { static constexpr bool value = true; };
typedef f32x4 Acc[2][2][4][2];

DI void store_tile_bf16(const Acc& acc, bf16_t* O, long ldc, long row_base, int col_base, float sc, int wr, int wc, int fr, int fq) {
#pragma unroll
    for (int ai = 0; ai < 2; ++ai)
#pragma unroll
        for (int m = 0; m < 4; ++m) {
            bf16_t* rowp = O + (row_base + ai * HALF + wr * 64 + m * 16 + fr) * ldc + col_base + wc * 32 + 8 * fq;
#pragma unroll
            for (int bj = 0; bj < 2; ++bj) {
                const f32x4 v0 = acc[ai][bj][m][0] * sc, v1 = acc[ai][bj][m][1] * sc;
                u32x4 w; w.x = cvt_pk_bf16(v0[0], v0[1]); w.y = cvt_pk_bf16(v0[2], v0[3]); w.z = cvt_pk_bf16(v1[0], v1[1]); w.w = cvt_pk_bf16(v1[2], v1[3]);
                *(u32x4*)(rowp + bj * HALF) = w;
            }
        }
}
struct EpiBf16 {
    static constexpr bool PERM = true, AFTER_DRAIN = false;
    bf16_t* O; int ldc; float sc;
    DI void operator()(const Acc& acc, const Unit& u, int wr, int wc, int fr, int fq) const { store_tile_bf16(acc, O, ldc, (long)u.pm * BM, u.pn * BM, sc, wr, wc, fr, fq); }
};
constexpr int RSTD_OFF = RING_BYTES + 4096;
DI void rows_rstd(const float* ssq, LAS float* rsl, int pm, int& cur_pm, int wr, int wc, int fr, int fq, float (&rs)[2][4]) {
    if (pm != cur_pm) {
        cur_pm = pm;
        const int t = (wr * 4 + wc) * 64 + fq * 16 + fr;
        const f32x4* pp = (const f32x4*)(ssq + ((long)pm * BM + (t >> 1)) * 32 + 16 * (t & 1));
        const f32x4 a = pp[0], b = pp[1], c = pp[2], d = pp[3];
        float s = (((a[0] + a[1]) + (a[2] + a[3])) + ((b[0] + b[1]) + (b[2] + b[3]))) + (((c[0] + c[1]) + (c[2] + c[3])) + ((d[0] + d[1]) + (d[2] + d[3])));
        const float o = __shfl_xor(s, 1);
        if (!(t & 1)) rsl[t >> 1] = rsqrtf((s + o) * (1.f / D) + EPS);
        asm volatile("s_waitcnt lgkmcnt(0)" ::: "memory"); __builtin_amdgcn_s_barrier();
    }
#pragma unroll
    for (int ai = 0; ai < 2; ++ai)
#pragma unroll
        for (int m = 0; m < 4; ++m) rs[ai][m] = rsl[ai * HALF + wr * 64 + m * 16 + fr];
}
struct EpiBf16N {
    static constexpr bool PERM = true, AFTER_DRAIN = false;
    bf16_t* O; int ldc; const float* ssq; const float* bias; int ldbias; mutable int cur_pm; LAS float* rsl;
    DI void prefetch(const Unit& u, int wid, int lane) const {
        if (wid != 0) return;
        const long rb = (long)u.pm * BM; const int bidx = rb < NL ? (int)(rb >> 13) : 4;
        __builtin_amdgcn_global_load_lds((const unsigned*)(bias + bidx * ldbias + u.pn * BM + lane * 4), (LAS unsigned*)(rsl + 256 + u.par * 256), 16, 0, 0);
    }
    DI void operator()(const Acc& acc, const Unit& u, int wr, int wc, int fr, int fq) const {
        asm volatile("" : "+v"(fr), "+v"(fq));
        const long rb = (long)u.pm * BM;
        float rs[2][4]; rows_rstd(ssq, rsl, u.pm, cur_pm, wr, wc, fr, fq, rs);
        const LAS float* bp = rsl + 256 + u.par * 256 + wc * 32 + 8 * fq;
        f32x4 bv[2][2];
#pragma unroll
        for (int bj = 0; bj < 2; ++bj) { bv[bj][0] = *(const LAS f32x4*)(bp + bj * HALF); bv[bj][1] = *(const LAS f32x4*)(bp + bj * HALF + 4); }
#pragma unroll
        for (int ai = 0; ai < 2; ++ai)
#pragma unroll
            for (int m = 0; m < 4; ++m) {
                bf16_t* rowp = O + (rb + ai * HALF + wr * 64 + m * 16 + fr) * ldc + u.pn * BM + wc * 32 + 8 * fq;
                const float r = rs[ai][m];
#pragma unroll
                for (int bj = 0; bj < 2; ++bj) {
                    const f32x4 v0 = acc[ai][bj][m][0] * r + bv[bj][0], v1 = acc[ai][bj][m][1] * r + bv[bj][1];
                    u32x4 w; w.x = cvt_pk_bf16(v0[0], v0[1]); w.y = cvt_pk_bf16(v0[2], v0[3]); w.z = cvt_pk_bf16(v1[0], v1[1]); w.w = cvt_pk_bf16(v1[2], v1[3]);
                    *(u32x4*)(rowp + bj * HALF) = w;
                }
            }
    }
};
struct EpiQK {
    static constexpr bool PERM = true, AFTER_DRAIN = false;
    bf16_t* Q; bf16_t* Kk; float qscale;
    DI void operator()(const Acc& acc, const Unit& u, int wr, int wc, int fr, int fq) const {
        const int h = u.pn >> 1, j = u.pn & 1;
        store_tile_bf16(acc, j ? Kk : Q, 1024, (long)u.pm * BM, h * 256, j ? 1.f : qscale, wr, wc, fr, fq);
    }
};
struct EpiRG {
    static constexpr bool PERM = true, AFTER_DRAIN = false;
    const bf16_t* XCA; bf16_t* RG; bf16_t* IX; const float* br; const float* bi;
    DI void operator()(const Acc& acc, const Unit& u, int wr, int wc, int fr, int fq) const {
        const int blk = u.pn >> 1, d = u.pn & 1;
        const int ch0 = blk * 128 + wc * 32 + 8 * fq;
        const float* brp = br + d * 1024 + ch0; const float* bip = bi + d * 1024 + ch0;
        u32x4 xwv[2][4];
#pragma unroll
        for (int ai = 0; ai < 2; ++ai)
#pragma unroll
            for (int m = 0; m < 4; ++m) xwv[ai][m] = *(const u32x4*)(XCA + ((long)u.pm * BM + ai * HALF + wr * 64 + m * 16 + fr) * 1024 + ch0);
        f32x4 b_rv[2], b_iv[2];
#pragma unroll
        for (int n = 0; n < 2; ++n) { b_rv[n] = *(const f32x4*)(brp + 4 * n); b_iv[n] = *(const f32x4*)(bip + 4 * n); }
#pragma unroll
        for (int ai = 0; ai < 2; ++ai)
#pragma unroll
            for (int m = 0; m < 4; ++m) {
                const long row = (long)u.pm * BM + ai * HALF + wr * 64 + m * 16 + fr;
                const u32x4 xw = xwv[ai][m];
                const unsigned xws[4] = {xw.x, xw.y, xw.z, xw.w};
                unsigned ro[4], io[4];
#pragma unroll
                for (int n = 0; n < 2; ++n) {
                    const f32x4 b_r = b_rv[n], b_i = b_iv[n];
                    float r[4], ig[4];
#pragma unroll
                    for (int q = 0; q < 4; ++q) { r[q] = sigmoidf_(acc[ai][0][m][n][q] + b_r[q]); ig[q] = sigmoidf_(acc[ai][1][m][n][q] + b_i[q]); }
                    const float x0 = bf2f(xws[2 * n] & 0xffffu), x1 = bf2f(xws[2 * n] >> 16), x2 = bf2f(xws[2 * n + 1] & 0xffffu), x3 = bf2f(xws[2 * n + 1] >> 16);
                    ro[2 * n] = cvt_pk_bf16(r[0], r[1]); ro[2 * n + 1] = cvt_pk_bf16(r[2], r[3]);
                    io[2 * n] = cvt_pk_bf16(ig[0] * x0, ig[1] * x1); io[2 * n + 1] = cvt_pk_bf16(ig[2] * x2, ig[3] * x3);
                }
                *(u32x4*)(RG + ((long)d * NT + row) * 1024 + ch0) = (u32x4){ro[0], ro[1], ro[2], ro[3]};
                *(u32x4*)(IX + ((long)d * NT + row) * 1024 + ch0) = (u32x4){io[0], io[1], io[2], io[3]};
                asm volatile("" ::: "memory");
            }
    }
};
struct EpiGates {
    static constexpr bool PERM = false, AFTER_DRAIN = false;
    float* GT; const float* bif;
    DI void operator()(const Acc& acc, const Unit& u, int wr, int wc, int fr, int fq) const {
        if (wc != 0) return;
        const f32x4 bv = *(const f32x4*)(bif + 4 * fq);
#pragma unroll
        for (int ai = 0; ai < 2; ++ai)
#pragma unroll
            for (int m = 0; m < 4; ++m) {
                const long row = (long)u.pm * BM + ai * HALF + wr * 64 + m * 16 + fr;
                *(f32x4*)(GT + row * 16 + 4 * fq) = acc[ai][0][m][0] + bv;
            }
    }
};
template <int AOUT> struct EpiResidT {
    static constexpr bool PERM = true, AFTER_DRAIN = false;
    const float* srcLi; const float* srcCi; const float* gam; unsigned char* ws; float* out;
    int layer, goff, perm; float sc;
    int nlayer, scoff, aperm;
    DI void operator()(const Acc& acc, const Unit& u, int wr, int wc, int fr, int fq) const {
        if constexpr (AOUT != 0) asm volatile("" : "+v"(fr), "+v"(fq));
        unsigned long pw = (unsigned long)ws, po = (unsigned long)out;
        unsigned pwl = __builtin_amdgcn_readfirstlane((unsigned)pw), pwh = __builtin_amdgcn_readfirstlane((unsigned)(pw >> 32)), pol = __builtin_amdgcn_readfirstlane((unsigned)po), poh = __builtin_amdgcn_readfirstlane((unsigned)(po >> 32));
        asm volatile("" : "+s"(pwl), "+s"(pwh), "+s"(pol), "+s"(poh));
        unsigned char* wsp = (unsigned char*)(((unsigned long)pwh << 32) | pwl); float* outp = (float*)(((unsigned long)poh << 32) | pol);
        float* const XCXp = (float*)(wsp + WS_XCX);
        const float* srcL = srcLi ? srcLi : outp; const float* srcC = srcCi ? srcCi : XCXp; float* dstL = outp; float* dstC = XCXp;
        const float* mod = (const float*)(wsp + WS_MOD) + layer * 5 * 12288; const float* nmod = (const float*)(wsp + WS_MOD) + nlayer * 5 * 12288;
        void* A = wsp + A_H; float* ssq = (float*)(wsp + WS_SSQ);
        const long rb = (long)u.pm * BM;
        const int bidx = rb < NL ? (int)(rb >> 13) : 4;
        const float* gate = mod + bidx * 12288 + goff;
        const int col0 = u.pn * BM + wc * 32 + 8 * fq;
        f32x4 gv[2][2], gm[2][2];
#pragma unroll
        for (int bj = 0; bj < 2; ++bj)
#pragma unroll
            for (int n = 0; n < 2; ++n) {
                gv[bj][n] = *(const f32x4*)(gate + col0 + bj * HALF + n * 4) * sc;
                if constexpr (AOUT != 0) gm[bj][n] = *(const f32x4*)(gam + col0 + bj * HALF + n * 4) * (*(const f32x4*)(nmod + bidx * 12288 + scoff + col0 + bj * HALF + n * 4) + 1.f) * (AOUT == 1 ? S8_H : 1.f);
            }
        f32x4 sv[2][4];
#pragma unroll
        for (int it = 0; it < 8 + 1; ++it) {
            if (it < 8) {
                const int ai = it >> 2, m = it & 3;
                const long row = rb + ai * HALF + wr * 64 + m * 16 + fr;
                const float* s;
                if (row < NL) { long orow = row; if (perm) { const int b = (int)(row >> 13), tp = (int)(row & 8191), j = tp >> 7, i = tp & 127; orow = ((long)b << 13) + i * 64 + j; } s = srcL + orow * D; }
                else s = srcC + (row - NL) * D;
#pragma unroll
                for (int bj = 0; bj < 2; ++bj) { sv[it % 2][2 * bj] = __builtin_nontemporal_load((const f32x4*)(s + col0 + bj * HALF)); sv[it % 2][2 * bj + 1] = __builtin_nontemporal_load((const f32x4*)(s + col0 + bj * HALF + 4)); }
            }
            if (it >= 1) {
                const int ir = it - 1, ai = ir >> 2, m = ir & 3;
                const long row = rb + ai * HALF + wr * 64 + m * 16 + fr;
                float* dd; long arow = row;
                if (row < NL) {
                    long orow = row;
                    if (perm) { const int b = (int)(row >> 13), tp = (int)(row & 8191), j = tp >> 7, i = tp & 127; orow = ((long)b << 13) + i * 64 + j; }
                    dd = dstL + orow * D;
                    if (AOUT != 0 && aperm) { const int t = (int)(row & 8191), i = t >> 6, j = t & 63; arow = (row & ~8191L) + j * 128 + i; }
                } else dd = dstC + (row - NL) * D;
                float ss = 0.f;
#pragma unroll
                for (int bj = 0; bj < 2; ++bj) {
                    const int c = col0 + bj * HALF;
                    const f32x4 x0 = sv[ir % 2][2 * bj] + gv[bj][0] * acc[ai][bj][m][0], x1 = sv[ir % 2][2 * bj + 1] + gv[bj][1] * acc[ai][bj][m][1];
                    __builtin_nontemporal_store(x0, (f32x4*)(dd + c)); __builtin_nontemporal_store(x1, (f32x4*)(dd + c + 4));
                    if constexpr (AOUT != 0) {
                        ss += ((x0[0] * x0[0] + x0[1] * x0[1]) + (x0[2] * x0[2] + x0[3] * x0[3])) + ((x1[0] * x1[0] + x1[1] * x1[1]) + (x1[2] * x1[2] + x1[3] * x1[3]));
                        const f32x4 a0 = x0 * gm[bj][0], a1 = x1 * gm[bj][1];
                        if constexpr (AOUT == 1) { u32x2 w; w.x = pack4_fp8(a0[0], a0[1], a0[2], a0[3]); w.y = pack4_fp8(a1[0], a1[1], a1[2], a1[3]); *(u32x2*)((unsigned char*)A + arow * D + c) = w; }
                        else { u32x4 w; w.x = cvt_pk_bf16(a0[0], a0[1]); w.y = cvt_pk_bf16(a0[2], a0[3]); w.z = cvt_pk_bf16(a1[0], a1[1]); w.w = cvt_pk_bf16(a1[2], a1[3]); *(u32x4*)((bf16_t*)A + arow * D + c) = w; }
                    }
                }
                if constexpr (AOUT != 0) {
                    ss += __shfl_xor(ss, 16); ss += __shfl_xor(ss, 32);
                    if (fq == 0) ssq[arow * 32 + u.pn * 4 + wc] = ss;
                }
            }
        }
    }
};
typedef EpiResidT<0> EpiResid;
template <bool OUT8> struct EpiSwiglu {
    static constexpr bool PERM = true, AFTER_DRAIN = false;
    void* O; int ntn; float sin;
    const float* ssq; const float* bias; mutable int cur_pm; LAS float* rsl;
    DI void prefetch(const Unit& u, int wid, int lane) const {
        if (!ssq || wid != 0) return;
        const long rb = (long)u.pm * BM; const int bidx = rb < NL ? (int)(rb >> 13) : 4; const int pc = u.pn % ntn;
        __builtin_amdgcn_global_load_lds((const unsigned*)(bias + bidx * FF2 + pc * 128 + (lane & 31) * 4 + (lane >> 5) * FF), (LAS unsigned*)(rsl + 256 + u.par * 256), 16, 0, 0);
    }
    DI void operator()(const Acc& acc, const Unit& u, int wr, int wc, int fr, int fq) const {
        asm volatile("" : "+v"(fr), "+v"(fq));
        const int pc = u.pn % ntn;
        float rs[2][4]; f32x4 ba[2], bb[2];
#pragma unroll
        for (int ai = 0; ai < 2; ++ai)
#pragma unroll
            for (int m = 0; m < 4; ++m) rs[ai][m] = 1.f;
#pragma unroll
        for (int n = 0; n < 2; ++n) { ba[n] = (f32x4){0.f, 0.f, 0.f, 0.f}; bb[n] = ba[n]; }
        if (ssq) {
            const LAS float* bp = rsl + 256 + u.par * 256 + wc * 32 + 8 * fq;
#pragma unroll
            for (int n = 0; n < 2; ++n) { ba[n] = *(const LAS f32x4*)(bp + 4 * n); bb[n] = *(const LAS f32x4*)(bp + 128 + 4 * n) * (OUT8 ? S8_ACT : 1.f); }
            rows_rstd(ssq, rsl, u.pm, cur_pm, wr, wc, fr, fq, rs);
        }
#pragma unroll
        for (int ai = 0; ai < 2; ++ai)
#pragma unroll
            for (int m = 0; m < 4; ++m) {
                const long row = (long)u.pm * BM + ai * HALF + wr * 64 + m * 16 + fr;
                const float sa = sin * rs[ai][m];
                if constexpr (OUT8) {
                    unsigned char* op = (unsigned char*)O + row * FF + pc * 128 + wc * 32 + 8 * fq;
#pragma unroll
                    for (int n = 0; n < 2; ++n) {
                        const f32x4 a = acc[ai][0][m][n] * sa + ba[n], b = acc[ai][1][m][n] * (sa * S8_ACT) + bb[n];
                        *(unsigned*)(op + 4 * n) = pack4_fp8(siluf_(a[0]) * b[0], siluf_(a[1]) * b[1], siluf_(a[2]) * b[2], siluf_(a[3]) * b[3]);
                    }
                    asm volatile("" ::: "memory");
                    continue;
                }
                float o[8];
#pragma unroll
                for (int n = 0; n < 2; ++n)
#pragma unroll
                    for (int q = 0; q < 4; ++q) { const float a = acc[ai][0][m][n][q] * sa + ba[n][q], b = acc[ai][1][m][n][q] * sa + bb[n][q]; o[4 * n + q] = siluf_(a) * b; }
                if constexpr (OUT8) { }
                else *(u32x4*)((bf16_t*)O + row * FF + pc * 128 + wc * 32 + 8 * fq) = pack8(o);
            }
    }
};
struct EpiGlu {
    static constexpr bool PERM = true, AFTER_DRAIN = false;
    const float* YSUM; const float* gb; bf16_t* Y1;
    DI void operator()(const Acc& acc, const Unit& u, int wr, int wc, int fr, int fq) const {
#pragma unroll
        for (int bj = 0; bj < 2; ++bj) {
            const int c0 = u.pn * BM + bj * HALF + wc * 32 + 8 * fq;
            const f32x4 b0 = *(const f32x4*)(gb + c0), b1 = *(const f32x4*)(gb + c0 + 4);
#pragma unroll
            for (int ai = 0; ai < 2; ++ai)
#pragma unroll
                for (int m = 0; m < 4; ++m) {
                    const long row = (long)u.pm * BM + ai * HALF + wr * 64 + m * 16 + fr;
                    const f32x4 y0 = *(const f32x4*)(YSUM + row * 512 + c0), y1 = *(const f32x4*)(YSUM + row * 512 + c0 + 4);
                    float o[8];
#pragma unroll
                    for (int q = 0; q < 4; ++q) { o[q] = y0[q] * sigmoidf_(acc[ai][bj][m][0][q] + b0[q]); o[4 + q] = y1[q] * sigmoidf_(acc[ai][bj][m][1][q] + b1[q]); }
                    *(u32x4*)(Y1 + row * MIX1 + c0) = pack8(o);
                }
        }
    }
};

struct EpiS5A {
    static constexpr bool PERM = true, AFTER_DRAIN = false;
    bf16_t* YI; float* SLOC;
    DI void operator()(const Acc& acc, const Unit& u, int wr, int wc, int fr, int fq) const {
        const int g = u.pn / 3, j = u.pn % 3;
#pragma unroll
        for (int ai = 0; ai < 2; ++ai)
#pragma unroll
            for (int m = 0; m < 4; ++m) {
                const long r = (long)u.pm * BM + ai * HALF + wr * 64 + m * 16 + fr;
#pragma unroll
                for (int bj = 0; bj < 2; ++bj) {
                    const int col0 = bj * HALF + wc * 32 + 8 * fq;
                    const f32x4 v0 = acc[ai][bj][m][0], v1 = acc[ai][bj][m][1];
                    if (j < 2) { u32x4 w; w.x = cvt_pk_bf16(v0[0], v0[1]); w.y = cvt_pk_bf16(v0[2], v0[3]); w.z = cvt_pk_bf16(v1[0], v1[1]); w.w = cvt_pk_bf16(v1[2], v1[3]);
                        *(u32x4*)(YI + ((((long)j * 2304 + r) * 32 + g) << 8) + col0) = w; }
                    else { float* p = SLOC + (((r * 32 + g)) << 8) + col0; *(f32x4*)p = v0; *(f32x4*)(p + 4) = v1; }
                }
            }
    }
};
struct EpiS5C {
    static constexpr bool PERM = true, AFTER_DRAIN = false;
    const bf16_t* YI; float* YS;
    DI void operator()(const Acc& acc, const Unit& u, int wr, int wc, int fr, int fq) const {
        const int d = u.pn >> 5, g = u.pn & 31;
        u32x4 yw[2][4][2];
#pragma unroll
        for (int ai = 0; ai < 2; ++ai)
#pragma unroll
            for (int m = 0; m < 4; ++m)
#pragma unroll
                for (int bj = 0; bj < 2; ++bj) {
                    const long r = (long)u.pm * BM + ai * HALF + wr * 64 + m * 16 + fr;
                    yw[ai][m][bj] = *(const u32x4*)(YI + ((((long)d * 2304 + r) * 32 + g) << 8) + bj * HALF + wc * 32 + 8 * fq);
                }
#pragma unroll
        for (int ai = 0; ai < 2; ++ai)
#pragma unroll
            for (int m = 0; m < 4; ++m) {
                const long r = (long)u.pm * BM + ai * HALF + wr * 64 + m * 16 + fr;
#pragma unroll
                for (int bj = 0; bj < 2; ++bj) {
                    const int col0 = bj * HALF + wc * 32 + 8 * fq, t = col0 >> 4, h0 = col0 & 15;
                    float yi[8]; unpack8(yw[ai][m][bj], yi);
                    const f32x4 v0 = acc[ai][bj][m][0], v1 = acc[ai][bj][m][1];
                    float* p = YS + ((long)d * NL + r * 16 + t) * 512 + g * 16 + h0;
                    *(f32x4*)p = (f32x4){v0[0] + yi[0], v0[1] + yi[1], v0[2] + yi[2], v0[3] + yi[3]};
                    *(f32x4*)(p + 4) = (f32x4){v1[0] + yi[4], v1[1] + yi[5], v1[2] + yi[6], v1[3] + yi[7]};
                }
            }
    }
};

typedef int i32x4v __attribute__((ext_vector_type(4)));
typedef int i32x8v __attribute__((ext_vector_type(8)));
DI i32x8v cat8(bf16x8 lo, bf16x8 hi) { const i32x4v a = __builtin_bit_cast(i32x4v, lo), b = __builtin_bit_cast(i32x4v, hi); return __builtin_shufflevector(a, b, 0, 1, 2, 3, 4, 5, 6, 7); }
template <bool FP8 = false, class Epi, class Sch, bool ALIGN_EPI = true, bool SP2 = true, int AMODE = 0>
DI void gemm_phase(LAS unsigned char* lds, const Gemm g, const Sch& S, const Epi& E) {
    int tid = threadIdx.x; asm volatile("" : "+v"(tid));
    const int wid = __builtin_amdgcn_readfirstlane(tid >> 6), lane = tid & 63, wr = wid >> 2, wc = wid & 3, fr = lane & 15, fq = lane >> 4;
    int K = g.K, lda_ = g.lda, ldb_ = g.ldb; constexpr int amode_ = AMODE; asm volatile("" : "+s"(K), "+s"(lda_), "+s"(ldb_));
    const int nt = K / BK;
    unsigned voffA, voffB;
    { int R, C; stage_rc(tid * 16, R, C); const int Rb = Epi::PERM ? ((R & ~31) + perm32(R & 31)) : R;
        voffA = amode_ ? (unsigned)((R * 16 + (C >> 4)) * lda_ + (C & 15)) * 2u : (unsigned)(R * lda_ + C) * 2u; voffB = (unsigned)(Rb * ldb_ + C) * 2u; }
    const unsigned pstepA = (amode_ ? 16u : 1u) * 64u * lda_ * 2u, pstepB = 64u * ldb_ * 2u;
    const char* const baseA = (const char*)g.A; const char* const baseB = (const char*)g.Bt;
    const unsigned kstep = (unsigned)(BK * 2);
    const unsigned kstepA = amode_ ? 4u * lda_ * 2u : kstep;
    const unsigned hstepA = (amode_ ? 16u : 1u) * HALF * lda_ * 2u, hstepB = (unsigned)HALF * ldb_ * 2u;
    const unsigned ldsw = (unsigned)wid * 1024u;
    const int aoff0 = lds_byte(wr * 64 + fr, fq * 8), boff0 = lds_byte(wc * 32 + fr, fq * 8);
    constexpr int KOFF = 1024;
    const LAS unsigned char* ldsA = lds + aoff0; const LAS unsigned char* ldsB = lds + boff0;
#define PG8_SA(b, h) (((b) * 2 + (h)) * HTB)
#define PG8_SB(b, h) ((4 + (b) * 2 + (h)) * HTB)
#define PG8_STAGE(bufoff, gbase, voff) do { _Pragma("unroll") for (int _i = 0; _i < 2; ++_i) { unsigned _vo = (voff); if constexpr (FP8) asm volatile("" : "+v"(_vo)); \
        __builtin_amdgcn_global_load_lds((const unsigned*)(base_##voff + (unsigned)((gbase) + _i * pstep_##voff + _vo)), (LAS unsigned*)(lds + (bufoff) + ldsw + _i * 8192), 16, 0, 0); } } while (0)
#define pstep_voffA pstepA
#define pstep_voffB pstepB
#define base_voffA baseA
#define base_voffB baseB
#define PG8_LDA(dst, b, h) do { _Pragma("unroll") for (int m = 0; m < 4; ++m) { \
        if constexpr (FP8) { dst##8[m].lo = *(const LAS i32x4v*)(ldsA + PG8_SA(b, h) + m * 2048); dst##8[m].hi = *(const LAS i32x4v*)(ldsA + PG8_SA(b, h) + KOFF + m * 2048); } \
        else { _Pragma("unroll") for (int k = 0; k < 2; ++k) dst[m][k] = *(const LAS bf16x8*)(ldsA + PG8_SA(b, h) + k * KOFF + m * 2048); } } } while (0)
#define PG8_LDB(dst, b, h) do { _Pragma("unroll") for (int n = 0; n < 2; ++n) { \
        if constexpr (FP8) { dst##8[n].lo = *(const LAS i32x4v*)(ldsB + PG8_SB(b, h) + n * 2048); dst##8[n].hi = *(const LAS i32x4v*)(ldsB + PG8_SB(b, h) + KOFF + n * 2048); } \
        else { _Pragma("unroll") for (int k = 0; k < 2; ++k) dst[n][k] = *(const LAS bf16x8*)(ldsB + PG8_SB(b, h) + k * KOFF + n * 2048); } } } while (0)
#define PG8_MMA(ai, bj, At, Bt) do { __builtin_amdgcn_s_setprio(1); _Pragma("unroll") for (int m = 0; m < 4; ++m) _Pragma("unroll") for (int n = 0; n < 2; ++n) { \
        if constexpr (FP8) asm volatile("v_mfma_f32_16x16x128_f8f6f4 %0, %1, %2, %0" : "+v"(acc[ai][bj][m][n]) : "v"(Bt##8[n]), "v"(At##8[m]));   \
        else { _Pragma("unroll") for (int k = 0; k < 2; ++k) acc[ai][bj][m][n] = __builtin_amdgcn_mfma_f32_16x16x32_bf16(Bt[n][k], At[m][k], acc[ai][bj][m][n], 0, 0, 0); } } \
        __builtin_amdgcn_s_setprio(0); } while (0)
#define PG8_WAIT_V(n) asm volatile("s_waitcnt vmcnt(" #n ")" ::: "memory")
#define PG8_WAIT_L(n) asm volatile("s_waitcnt lgkmcnt(" #n ")" ::: "memory")
#define PG8_BAR __builtin_amdgcn_s_barrier()
#define PG8_SCHED __builtin_amdgcn_sched_barrier(0)
    Unit cur, nxt; int ui = 0;
    if (!S.next(0, cur)) return;
    Acc acc;
#pragma unroll
    for (int a = 0; a < 2; ++a)
#pragma unroll
        for (int b = 0; b < 2; ++b)
#pragma unroll
            for (int m = 0; m < 4; ++m)
#pragma unroll
                for (int n = 0; n < 2; ++n) acc[a][b][m][n] = (f32x4){0.f, 0.f, 0.f, 0.f};
    bf16x8 At[4][2], B0[2][2], B1[2][2];
    i32x8v At8[4], B08[2], B18[2];
    (void)At; (void)B0; (void)B1; (void)At8; (void)B08; (void)B18;
    unsigned cA = (unsigned)cur.aoff, cB = (unsigned)cur.boff;
    S.a_ready(cur);
    cur.par = 0; if constexpr (has_prefetch<Epi>::value) E.prefetch(cur, wid, lane);
    if constexpr (SP2) {
        PG8_STAGE(PG8_SB(0, 0), cB, voffB); PG8_STAGE(PG8_SB(0, 1), cB + hstepB, voffB); PG8_STAGE(PG8_SA(0, 0), cA, voffA); PG8_STAGE(PG8_SA(0, 1), cA + hstepA, voffA);
        if (wr == 1) PG8_BAR;
        PG8_WAIT_V(2); PG8_BAR;
        PG8_STAGE(PG8_SB(1, 0), cB + kstep, voffB); PG8_STAGE(PG8_SA(1, 0), cA + kstepA, voffA); PG8_STAGE(PG8_SB(1, 1), cB + hstepB + kstep, voffB);
        PG8_WAIT_V(6); PG8_BAR;
    } else {
        PG8_STAGE(PG8_SB(0, 0), cB, voffB); PG8_STAGE(PG8_SA(0, 0), cA, voffA); PG8_STAGE(PG8_SB(0, 1), cB + hstepB, voffB); PG8_STAGE(PG8_SA(0, 1), cA + hstepA, voffA);
        if (wr == 1) PG8_BAR;
        PG8_WAIT_V(4); PG8_BAR;
        PG8_STAGE(PG8_SB(1, 0), cB + kstep, voffB); PG8_STAGE(PG8_SA(1, 0), cA + kstepA, voffA); PG8_STAGE(PG8_SB(1, 1), cB + hstepB + kstep, voffB);
        PG8_WAIT_V(6); PG8_BAR;
    }
    for (;;) {
        const bool has_next = S.next(ui + 1, nxt); nxt.par = (ui + 1) & 1;
        const unsigned nA = has_next ? (unsigned)nxt.aoff : cA, nB = has_next ? (unsigned)nxt.boff : cB;
        for (int t = 0; t < nt; t += 2) {
            const bool last = (t == nt - 2);
            const unsigned a1 = cA + (unsigned)(t + 1) * kstepA;
            const unsigned a2 = last ? nA : cA + (unsigned)(t + 2) * kstepA, b2 = last ? nB : cB + (unsigned)(t + 2) * kstep;
            const unsigned a3 = a2 + kstepA, b3 = b2 + kstep;
            if (last && has_next) { S.a_ready(nxt); if constexpr (has_prefetch<Epi>::value) E.prefetch(nxt, wid, lane); }
            if constexpr (SP2) {
            PG8_LDB(B0, 0, 0); PG8_LDB(B1, 0, 1); PG8_SCHED; PG8_LDA(At, 0, 0); PG8_STAGE(PG8_SA(1, 1), a1 + hstepA, voffA);
            PG8_WAIT_V(8); PG8_WAIT_L(0); PG8_BAR; PG8_MMA(0, 0, At, B0); PG8_MMA(0, 1, At, B1); PG8_BAR; PG8_SCHED;
            PG8_LDA(At, 0, 1); PG8_STAGE(PG8_SB(0, 0), b2, voffB); PG8_STAGE(PG8_SB(0, 1), b2 + hstepB, voffB); PG8_STAGE(PG8_SA(0, 0), a2, voffA);
            PG8_WAIT_V(8); PG8_WAIT_L(0); PG8_BAR; PG8_MMA(1, 0, At, B0); PG8_MMA(1, 1, At, B1); PG8_BAR; PG8_SCHED;
            PG8_LDB(B0, 1, 0); PG8_LDB(B1, 1, 1); PG8_SCHED; PG8_LDA(At, 1, 0); PG8_STAGE(PG8_SA(0, 1), a2 + hstepA, voffA);
            PG8_WAIT_V(8); PG8_WAIT_L(0); PG8_BAR; PG8_MMA(0, 0, At, B0); PG8_MMA(0, 1, At, B1); PG8_BAR; PG8_SCHED;
            PG8_LDA(At, 1, 1); PG8_STAGE(PG8_SB(1, 0), b3, voffB); PG8_STAGE(PG8_SB(1, 1), b3 + hstepB, voffB); PG8_STAGE(PG8_SA(1, 0), a3, voffA);
            PG8_WAIT_V(8); PG8_WAIT_L(0); PG8_BAR; PG8_MMA(1, 0, At, B0); PG8_MMA(1, 1, At, B1); PG8_BAR; PG8_SCHED;
            } else {
            PG8_LDB(B0, 0, 0); PG8_SCHED; PG8_LDA(At, 0, 0); PG8_STAGE(PG8_SA(1, 1), a1 + hstepA, voffA);
            PG8_WAIT_L(8); PG8_BAR; PG8_WAIT_L(0); PG8_MMA(0, 0, At, B0); PG8_BAR; PG8_SCHED;
            PG8_LDB(B1, 0, 1); PG8_STAGE(PG8_SB(0, 0), b2, voffB);
            PG8_BAR; PG8_WAIT_L(0); PG8_MMA(0, 1, At, B1); PG8_BAR;
            PG8_LDA(At, 0, 1); PG8_STAGE(PG8_SA(0, 0), a2, voffA);
            PG8_BAR; PG8_WAIT_L(0); PG8_MMA(1, 0, At, B0); PG8_BAR; PG8_SCHED;
            PG8_STAGE(PG8_SB(0, 1), b2 + hstepB, voffB);
            PG8_WAIT_V(6); PG8_BAR; PG8_MMA(1, 1, At, B1); PG8_BAR;
            PG8_LDB(B0, 1, 0); PG8_SCHED; PG8_LDA(At, 1, 0); PG8_STAGE(PG8_SA(0, 1), a2 + hstepA, voffA);
            PG8_WAIT_L(8); PG8_BAR; PG8_WAIT_L(0); PG8_MMA(0, 0, At, B0); PG8_BAR; PG8_SCHED;
            PG8_LDB(B1, 1, 1); PG8_STAGE(PG8_SB(1, 0), b3, voffB);
            PG8_BAR; PG8_WAIT_L(0); PG8_MMA(0, 1, At, B1); PG8_BAR;
            PG8_LDA(At, 1, 1); PG8_STAGE(PG8_SA(1, 0), a3, voffA);
            PG8_BAR; PG8_WAIT_L(0); PG8_MMA(1, 0, At, B0); PG8_BAR; PG8_SCHED;
            PG8_STAGE(PG8_SB(1, 1), b3 + hstepB, voffB);
            PG8_WAIT_V(6); PG8_BAR; PG8_MMA(1, 1, At, B1); PG8_BAR;
            }
        }
        if constexpr (ALIGN_EPI) { if (wr == 0) PG8_BAR; }
        if constexpr (FP8) asm volatile("s_nop 15\n\ts_nop 15" ::: "memory");
        { int fr2 = fr, fq2 = fq; asm volatile("" : "+v"(fr2), "+v"(fq2));
          E(acc, cur, wr, wc, fr2, fq2); } S.done(cur);
        if (!has_next) break;
#pragma unroll
        for (int a = 0; a < 2; ++a)
#pragma unroll
            for (int b = 0; b < 2; ++b)
#pragma unroll
                for (int m = 0; m < 4; ++m)
#pragma unroll
                    for (int n = 0; n < 2; ++n) acc[a][b][m][n] = (f32x4){0.f, 0.f, 0.f, 0.f};
        cur = nxt; cA = nA; cB = nB; ++ui;
        if constexpr (ALIGN_EPI) { if (wr == 1) PG8_BAR; }
    }
    PG8_WAIT_V(0);
    if constexpr (!ALIGN_EPI) { if (wr == 0) PG8_BAR; }
    PG8_BAR;
#undef PG8_SA
#undef PG8_SB
#undef PG8_STAGE
#undef pstep_voffA
#undef pstep_voffB
#undef base_voffA
#undef base_voffB
#undef PG8_LDA
#undef PG8_LDB
#undef PG8_MMA
#undef PG8_WAIT_V
#undef PG8_WAIT_L
#undef PG8_BAR
#undef PG8_SCHED
}
}

#define XB_TMO      128
#define XB_XCNT(j)  (256  + 64 * (j))
#define XB_XSUB(j)  (1280 + 64 * (j))
#define XB_XGEN(j)  (2304 + 64 * (j))
#define XB_TOP      3328
#define XB_TOPGEN   3392
#define XCD_BAR_WORDS 3456
#define XB_SPIN_CAP (1u << 24)
DI unsigned xb_ld(unsigned* p)              { return __hip_atomic_load(p, __ATOMIC_RELAXED, __HIP_MEMORY_SCOPE_AGENT); }
DI unsigned xb_add(unsigned* p, unsigned v) { return __hip_atomic_fetch_add(p, v, __ATOMIC_RELAXED, __HIP_MEMORY_SCOPE_AGENT); }
DI unsigned xb_xcc_id() { return (unsigned)__builtin_amdgcn_s_getreg((3 << 11) | 20) & 0xFu; }
#define XB_SPIN(cond, bar) do { unsigned _sp = 0; while (cond) { __builtin_amdgcn_s_sleep(1); \
    if ((++_sp & 255u) == 0u) { if (xb_ld(&(bar)[XB_TMO])) break; if (_sp > XB_SPIN_CAP) { atomicAdd(&(bar)[XB_TMO], 1u); break; } } } } while (0)
struct XcdBarrier { unsigned* bar; unsigned x; volatile LAS unsigned* st; };
DI XcdBarrier xcd_barrier_post(unsigned* bar, volatile LAS unsigned* st) {
    XcdBarrier b; b.bar = bar; b.x = xb_xcc_id(); b.st = st;
    if (threadIdx.x == 0) (void)xb_add(&bar[XB_XCNT(b.x)], 1u);
    return b;
}
DI void xcd_barrier_complete(unsigned* bar, unsigned x, unsigned& nloc, unsigned& nx) {
    const unsigned G = gridDim.x * gridDim.y * gridDim.z;
    unsigned sum, cnt, mine, sp = 0u;
    for (;;) {
        sum = 0u; cnt = 0u; mine = 0u;
#pragma unroll
        for (unsigned j = 0; j < 16; ++j) { const unsigned c = xb_ld(&bar[XB_XCNT(j)]); sum += c; cnt += (c > 0u) ? 1u : 0u; mine = (j == x) ? c : mine; }
        if (sum == G) break;
        __builtin_amdgcn_s_sleep(1);
        if ((++sp & 255u) == 0u) { if (xb_ld(&bar[XB_TMO])) break; if (sp > XB_SPIN_CAP) { atomicAdd(&bar[XB_TMO], 1u); break; } }
    }
    nloc = mine > 0u ? mine : 1u; nx = cnt > 0u ? cnt : 1u;
}
DI void xcd_barrier(const XcdBarrier& b) {
    asm volatile("s_waitcnt vmcnt(0)" ::: "memory");
    __syncthreads();
    if (threadIdx.x == 0) {
        unsigned* bar = b.bar;
        __builtin_amdgcn_s_waitcnt(0);
        unsigned nloc = b.st[0], nx = b.st[1];
        if (nloc == 0u) { xcd_barrier_complete(bar, b.x, nloc, nx); b.st[0] = nloc; b.st[1] = nx; }
        const unsigned old = xb_add(&bar[XB_XSUB(b.x)], 1u);
        const unsigned gen = old / nloc;
        if (old + 1u == (gen + 1u) * nloc) {
            __builtin_amdgcn_fence(__ATOMIC_RELEASE, "agent");
            asm volatile("s_waitcnt vmcnt(0)" ::: "memory");
            const unsigned og = xb_add(&bar[XB_TOP], 1u);
            const unsigned tg = og / nx;
            if (og + 1u == (tg + 1u) * nx) xb_add(&bar[XB_TOPGEN], 1u);
            else XB_SPIN(xb_ld(&bar[XB_TOPGEN]) == tg, bar);
            __builtin_amdgcn_fence(__ATOMIC_ACQUIRE, "agent");
            xb_add(&bar[XB_XGEN(b.x)], 1u);
            asm volatile("s_waitcnt vmcnt(0)" ::: "memory");
        } else {
            XB_SPIN(xb_ld(&bar[XB_XGEN(b.x)]) == gen, bar);
            __builtin_amdgcn_fence(__ATOMIC_ACQUIRE, "agent");
            asm volatile("s_waitcnt vmcnt(0)" ::: "memory");
        }
    }
    __syncthreads();
}

struct Params { const float* in[N_IN]; float* out; unsigned char* ws; int lo, hi, li, pad; };
static_assert(sizeof(Params) == (N_IN + 2) * 8 + 16, "Params has no padding");

struct Frame {
    LAS unsigned char* lds;
    int tid, lane, wave, G, bid;
    const float* const* in; float* out; unsigned char* ws;
};
#define WSP(T_, off) ((T_*)(F.ws + (off)))

struct TrJob { const float* src; unsigned char* dst; int K, N, r0, k0; float sc; int out8; };
DI void tr_load(const TrJob& j, int lane, float (&v)[32]) {
#pragma unroll
    for (int i = 0; i < 32; ++i) v[i] = __builtin_nontemporal_load(j.src + (size_t)(2 * i + (lane >> 5)) * j.N + (lane & 31));
}
DI void tr_store(const TrJob& j, int lane, const float (&v)[32], LAS float* scr) {
#pragma unroll
    for (int i = 0; i < 32; ++i) scr[(2 * i + (lane >> 5)) * 33 + (lane & 31)] = v[i];
    asm volatile("s_waitcnt lgkmcnt(0)" ::: "memory");
    const int c = lane & 7;
#pragma unroll
    for (int q = 0; q < 4; ++q) { const int n = (lane >> 3) + 8 * q; const LAS float* sp = scr + (8 * c) * 33 + n;
        if (j.out8) { const float sc = j.sc; u32x2 o; o.x = pack4_fp8(sp[0 * 33] * sc, sp[1 * 33] * sc, sp[2 * 33] * sc, sp[3 * 33] * sc); o.y = pack4_fp8(sp[4 * 33] * sc, sp[5 * 33] * sc, sp[6 * 33] * sc, sp[7 * 33] * sc);
            __builtin_nontemporal_store(o, (u32x2*)(j.dst + (size_t)(j.r0 + n) * j.K + j.k0 + 8 * c)); }
        else { u32x4 o; o.x = cvt_pk_bf16(sp[0 * 33], sp[1 * 33]); o.y = cvt_pk_bf16(sp[2 * 33], sp[3 * 33]); o.z = cvt_pk_bf16(sp[4 * 33], sp[5 * 33]); o.w = cvt_pk_bf16(sp[6 * 33], sp[7 * 33]);
            __builtin_nontemporal_store(o, (u32x4*)((bf16_t*)j.dst + (size_t)(j.r0 + n) * j.K + j.k0 + 8 * c)); } }
    asm volatile("s_waitcnt lgkmcnt(0)" ::: "memory");
}
DI TrJob tr_make(const float* W, int K, int N, void* WT, int row_off, int mode, int item, int out8, float sc) {
    const int nblk = N / 32, kb = item / nblk, nb = item % nblk; const int n0 = nb * 32;
    int r0;
    if (mode == 0) r0 = row_off + n0;
    else { const int half = n0 >= FF ? 1 : 0; const int nn = n0 - half * FF; r0 = row_off + (nn >> 7) * 256 + half * 128 + (nn & 127); }
    TrJob j; j.src = W + (size_t)(64 * kb) * N + n0; j.dst = (unsigned char*)WT; j.K = K; j.N = N; j.r0 = r0; j.k0 = 64 * kb; j.sc = sc; j.out8 = out8; return j;
}
namespace trc {
constexpr int J_IN0 = (D / 64) * (IN0 / 32), J_OUT0 = (D / 64) * (D / 32), J_FWI = (D / 64) * (FF2 / 32), J_FWO = (FF / 64) * (D / 32),
              J_IN1 = (D / 64) * (IN1 / 32), J_OUT1 = (MIX1 / 64) * (D / 32), J_GLU = (512 / 64) * (512 / 32), J_RG1 = (128 / 64) * (128 / 32), J_QKV1 = (256 / 64) * (256 / 32);
constexpr int TR_MOE = 8 * J_FWI + 8 * J_FWO;
constexpr int NITEMS = TR_MOE + J_IN0 + J_OUT0 + J_FWI + J_FWO + J_IN1 + J_OUT1 + J_GLU + 32 * J_RG1 + 12 * J_QKV1;
}
DI TrJob tr_job_of(Frame& F, int it) {
    using namespace trc;
    int r = it;
    if (r < 8 * J_FWI) { const int e = r / J_FWI; return tr_make(F.in[I1_MWI] + (size_t)e * D * FF2, D, FF2, WSP(unsigned char, WT_MWI) + (size_t)e * FF2 * D * (FP8_MOE ? 1 : 2), 0, 1, r % J_FWI, FP8_MOE, S8_W1); } r -= 8 * J_FWI;
    if (r < 8 * J_FWO) { const int e = r / J_FWO; return tr_make(F.in[I1_MWO] + (size_t)e * FF * D, FF, D, WSP(unsigned char, WT_MWO) + (size_t)e * D * FF * (FP8_MOE ? 1 : 2), 0, 0, r % J_FWO, FP8_MOE, S8_W2); } r -= 8 * J_FWO;
    if (r < J_IN0) return tr_make(F.in[I0_WIN], D, IN0, WSP(bf16_t, WT_IN0), 0, 0, r, 0, 1.f); r -= J_IN0;
    if (r < J_OUT0) return tr_make(F.in[I0_WOUT], D, D, WSP(bf16_t, WT_OUT0), 0, 0, r, 0, 1.f); r -= J_OUT0;
    if (r < J_FWI) return tr_make(F.in[I0_FWI], D, FF2, WSP(unsigned char, WT_FWI0), 0, 1, r, FP8_FFN, S8_W1); r -= J_FWI;
    if (r < J_FWO) return tr_make(F.in[I0_FWO], FF, D, WSP(unsigned char, WT_FWO0), 0, 0, r, FP8_FFN, S8_W2); r -= J_FWO;
    if (r < J_IN1) return tr_make(F.in[I1_WIN], D, IN1, WSP(bf16_t, WT_IN1), 0, 0, r, 0, 1.f); r -= J_IN1;
    if (r < J_OUT1) return tr_make(F.in[I1_WOUT], MIX1, D, WSP(bf16_t, WT_OUT1), 0, 0, r, 0, 1.f); r -= J_OUT1;
    if (r < J_GLU) return tr_make(F.in[I1_GLUW], 512, 512, WSP(bf16_t, WT_GLU), 0, 0, r, 0, 1.f); r -= J_GLU;
    if (r < 32 * J_RG1) { const int j = r / J_RG1, which = j >> 4, d = (j >> 3) & 1, blk = j & 7;
        return tr_make(F.in[which ? I0_AWI : I0_AWR] + (size_t)(d * 8 + blk) * 128 * 128, 128, 128, WSP(bf16_t, WT_RG), blk * 512 + d * 256 + which * 128, 0, r % J_RG1, 0, 1.f); } r -= 32 * J_RG1;
    const int j = r / J_QKV1, which = j >> 2, h = j & 3;
    const float* src = F.in[which == 0 ? I0_BWQ : (which == 1 ? I0_BWK : I0_BWV)] + (size_t)h * 256 * 256;
    if (which < 2) return tr_make(src, 256, 256, WSP(bf16_t, WT_QK), h * 512 + which * 256, 0, r % J_QKV1, 0, 1.f);
    return tr_make(src, 256, 256, WSP(bf16_t, WT_V), h * 256, 0, r % J_QKV1, 0, 1.f);
}
DI void tr_run(Frame& F, int first, int end, int stride) {
    LAS float* scr = (LAS float*)(F.lds + F.wave * 16384);
    if (first >= end) return;
    TrJob cur = tr_job_of(F, first); float v[32]; tr_load(cur, F.lane, v);
    for (int it = first; it < end; it += stride) {
        const int nit = it + stride; TrJob nxt = cur; float w[32];
        if (nit < end) { nxt = tr_job_of(F, nit); tr_load(nxt, F.lane, w); }
        tr_store(cur, F.lane, v, scr);
        if (nit < end) {
#pragma unroll
            for (int i = 0; i < 32; ++i) v[i] = w[i];
            cur = nxt; }
    }
}
constexpr int TQ_IN0 = 88, TQ_OUT0 = 88, TQ_FWI = 40, TQ_FWO = 104, TQ_IN1 = 88;
constexpr int TB_IN0 = 0, TB_OUT0 = TB_IN0 + 192 * TQ_IN0, TB_FWI = TB_OUT0 + 224 * TQ_OUT0, TB_FWO = TB_FWI + 80 * TQ_FWI, TB_IN1 = TB_FWO + 224 * TQ_FWO, TR_DEFER = TB_IN1 + 68 * TQ_IN1;
static_assert(TR_DEFER <= trc::TR_MOE, "deferred items are expert-weight items");
DI void tail_convert(Frame& F, int nwg, int base, int quota) {
    if (F.G != 256) return;
    const int r = nwg % 256; if (r == 0 || F.bid < r) return;
    const int lo = base + (F.bid - r) * quota;
    tr_run(F, lo + F.wave, lo + quota, 8);
    __syncthreads();
}
DI void s5_build_unit(Frame& F, int u);
DI void phase_prologue(Frame& F) {
    {
        LAS float* cact = (LAS float*)F.lds;
        LAS float* red = (LAS float*)(F.lds + 40960);
        bool have = false;
        for (int u = F.bid; u < 2 * 96; u += F.G) {
            if (!have) {
                { float tv[20];
#pragma unroll
                  for (int j = 0; j < 20; ++j) { const int i = F.tid + 512 * j, r = i >> 11, k = i & 2047; tv[j] = r < 4 ? F.in[I_C][r * 2048 + k] : F.in[I_CCTX][k]; }
#pragma unroll
                  for (int j = 0; j < 20; ++j) cact[F.tid + 512 * j] = siluf_(tv[j]); }
                have = true; __syncthreads();
            }
            const int l = u / 96, cb = u % 96;
            const float* W = F.in[l ? I1_MODW : I0_MODW]; const float* Bv = F.in[l ? I1_MODB : I0_MODB];
            const int cg = F.tid & 31, ks = F.tid >> 5;
            float acc[5][4];
#pragma unroll
            for (int r = 0; r < 5; ++r)
#pragma unroll
                for (int q = 0; q < 4; ++q) acc[r][q] = 0.f;
            const float* wp = W + (size_t)(ks * 128) * 12288 + cb * 128 + cg * 4;
            for (int k0 = 0; k0 < 128; k0 += 8) {
                f32x4 w[8];
#pragma unroll
                for (int k = 0; k < 8; ++k) w[k] = __builtin_nontemporal_load((const f32x4*)(wp + (size_t)(k0 + k) * 12288));
#pragma unroll
                for (int k = 0; k < 8; ++k)
#pragma unroll
                    for (int r = 0; r < 5; ++r) { const float a = cact[r * 2048 + ks * 128 + k0 + k]; acc[r][0] += a * w[k][0]; acc[r][1] += a * w[k][1]; acc[r][2] += a * w[k][2]; acc[r][3] += a * w[k][3]; }
            }
#pragma unroll
            for (int r = 0; r < 5; ++r)
#pragma unroll
                for (int q = 0; q < 4; ++q) red[(ks * 5 + r) * 128 + cg * 4 + q] = acc[r][q];
            __syncthreads();
            for (int i = F.tid; i < 5 * 128; i += 512) { const int r = i >> 7, c = i & 127; float s = 0.f;
#pragma unroll
                for (int k2 = 0; k2 < 16; ++k2) s += red[(k2 * 5 + r) * 128 + c];
                WSP(float, WS_MOD)[(l * 5 + r) * 12288 + cb * 128 + c] = s + Bv[cb * 128 + c]; }
            __syncthreads();
        }
        __syncthreads();
    }
    {
        for (int u = F.G - 1 - F.bid; u < 64; u += F.G) s5_build_unit(F, u);
        const int gt = F.bid * 512 + F.tid, GT = F.G * 512;
        bf16_t* GTW = WSP(bf16_t, WT_GT);
        for (int i = gt; i < 256 * 1024; i += GT) { const int r = i >> 10, k = i & 1023; float v = 0.f; if (r < 16) v = F.in[I0_BWIF][((r >> 3) * 1024 + k) * 8 + (r & 7)]; GTW[i] = f2bf(v); }
    }
    {
        __syncthreads();
        const int gw = F.bid * 8 + F.wave, NGW = F.G * 8;
        const int first = (F.G == 256) ? TR_DEFER : 0;
        tr_run(F, first + gw, trc::NITEMS, NGW);
    }
}

DI void s5_build_unit(Frame& F, int u) {
    const int d = u >> 5, g = u & 31;
    LAS float* pwr = (LAS float*)F.lds;
    LAS float* pwi = pwr + 17 * 64;
    LAS float* bbr = pwi + 17 * 64;
    LAS float* bbi = bbr + 64 * 16;
    LAS float* cr = bbi + 64 * 16;
    LAS float* ci = cr + 16 * 64;
    LAS float* kt = ci + 16 * 64;
    __syncthreads();
    if (F.tid < 64) {
        const int p = F.tid, i = (d * 32 + g) * 64 + p;
        const float dt = expf(F.in[I1_LDT][d * 32 + g]);
        const float lr = F.in[I1_LRE][i], lim = F.in[I1_LIM][i];
        for (int tau = 0; tau <= 16; ++tau) { const float mag = expf(lr * dt * (float)tau), ang = lim * dt * (float)tau; pwr[tau * 64 + p] = mag * cosf(ang); pwi[tau * 64 + p] = mag * sinf(ang); }
        const float ab_re = pwr[64 + p], ab_im = pwi[64 + p];
        const float den = lr * lr + lim * lim; const float nr = ab_re - 1.f, ni = ab_im;
        const float co_re = (nr * lr + ni * lim) / den, co_im = (ni * lr - nr * lim) / den;
        const float* bre = F.in[I1_BRE] + (g * 64 + p) * 16; const float* bim = F.in[I1_BIM] + (g * 64 + p) * 16;
        for (int h = 0; h < 16; ++h) { bbr[p * 16 + h] = co_re * bre[h] - co_im * bim[h]; bbi[p * 16 + h] = co_re * bim[h] + co_im * bre[h]; }
        WSP(float, WS_S5AB)[i * 2] = pwr[16 * 64 + p]; WSP(float, WS_S5AB)[i * 2 + 1] = pwi[16 * 64 + p];
    }
    for (int i = F.tid; i < 16 * 64; i += 512) { cr[i] = F.in[I1_CRE][(d * 32 + g) * 1024 + i]; ci[i] = F.in[I1_CIM][(d * 32 + g) * 1024 + i]; }
    __syncthreads();
    for (int e = F.tid; e < 4096; e += 512) {
        const int lag = e >> 8, h = (e >> 4) & 15, hp = e & 15; float acc = 0.f;
        for (int p = 0; p < 64; ++p) { const float ar = pwr[lag * 64 + p], ai = pwi[lag * 64 + p], br = bbr[p * 16 + hp], bi = bbi[p * 16 + hp];
            acc += cr[h * 64 + p] * (ar * br - ai * bi) - ci[h * 64 + p] * (ar * bi + ai * br); }
        kt[e] = acc;
    }
    __syncthreads();
    bf16_t* W1 = WSP(bf16_t, WT_S5W1) + (size_t)g * 768 * 256;
    for (int idx = F.tid; idx < 65536; idx += 512) {
        const int n = idx >> 8, k = idx & 255, t = n >> 4, h = n & 15, j = k >> 4, hp = k & 15; const int lag = d ? (j - t) : (t - j);
        W1[(size_t)(d * 256 + n) * 256 + k] = f2bf(lag >= 0 ? kt[(lag * 16 + h) * 16 + hp] : 0.f);
    }
    for (int idx = F.tid; idx < 32768; idx += 512) {
        const int n = idx >> 8, k = idx & 255, p = n & 63, j = k >> 4, hp = k & 15; const int lag = d ? j : (15 - j);
        const float ar = pwr[lag * 64 + p], ai = pwi[lag * 64 + p], br = bbr[p * 16 + hp], bi = bbi[p * 16 + hp];
        W1[(size_t)(512 + d * 128 + n) * 256 + k] = f2bf(n < 64 ? (ar * br - ai * bi) : (ar * bi + ai * br));
    }
    bf16_t* W3 = WSP(bf16_t, WT_S5W3) + (size_t)(d * 32 + g) * 256 * 128;
    for (int idx = F.tid; idx < 32768; idx += 512) {
        const int n = idx >> 7, k = idx & 127, t = n >> 4, h = n & 15, p = k & 63; const int lag = d ? (16 - t) : (t + 1);
        const float ar = pwr[lag * 64 + p], ai = pwi[lag * 64 + p], c_r = cr[h * 64 + p], c_i = ci[h * 64 + p];
        W3[(size_t)n * 128 + k] = f2bf(k < 64 ? (c_r * ar - c_i * ai) : -(c_r * ai + c_i * ar));
    }
    __syncthreads();
}
DI int s5_chunk_row(int d, int b, int step) {
    if (step < 16) { const int cc = d ? 15 - step : step; return 2048 + b * 16 + cc; }
    const int st = step - 16; const int cc = d ? 511 - st : st; return b * 512 + cc;
}
DI void phase_s5_carry(Frame& F) {
    const float* SLOC = WSP(float, A_SLOC); bf16_t* SIN = WSP(bf16_t, A_SIN);
    for (int id = F.bid + F.G * F.wave; id < 256; id += F.G * 8) {
        const int g = id & 31, b = (id >> 5) & 3, d = id >> 7, p = F.lane;
        const int si = (d * 32 + g) * 64 + p;
        const float a_re = WSP(float, WS_S5AB)[si * 2], a_im = WSP(float, WS_S5AB)[si * 2 + 1];
        float s_re = 0.f, s_im = 0.f;
        bf16_t* sin_dg = SIN + (size_t)(d * 32 + g) * S5ROWS * 128;
        for (int st0 = 0; st0 < 528; st0 += 16) {
            float lr[16], li[16]; int rr[16];
#pragma unroll
            for (int q = 0; q < 16; ++q) { rr[q] = s5_chunk_row(d, b, st0 + q); const float* sl = SLOC + (((size_t)rr[q] * 32 + g) << 8) + d * 128; lr[q] = sl[p]; li[q] = sl[64 + p]; }
#pragma unroll
            for (int q = 0; q < 16; ++q) {
                if (rr[q] < 2048) { sin_dg[(size_t)rr[q] * 128 + p] = f2bf(s_re); sin_dg[(size_t)rr[q] * 128 + 64 + p] = f2bf(s_im); }
                const float nr = a_re * s_re - a_im * s_im + lr[q], ni = a_re * s_im + a_im * s_re + li[q];
                s_re = nr; s_im = ni;
            }
        }
    }
}

template <bool OUT8 = false> DI void phase_norm(Frame& F, const float* srcL, const float* srcC, const float* gamma, const float* modl, int sh_off, int sc_off, void* H, bool permute, int nrows) {
    const int gw = F.bid * 8 + F.wave, NGW = F.G * 8;
    for (int row = gw; row < nrows; row += NGW) {
        const float* src = row < NL ? srcL + (size_t)row * D : srcC + (size_t)(row - NL) * D;
        const int bidx = row < NL ? (row >> 13) : 4;
        int drow = row;
        if (permute && row < NL) { const int t = row & 8191, i = t >> 6, j = t & 63; drow = (row & ~8191) + j * 128 + i; }
        const f32x4* xr = (const f32x4*)src + F.lane;
        f32x4 v[8]; float ss = 0.f;
#pragma unroll
        for (int j = 0; j < 8; ++j) { v[j] = xr[64 * j]; ss += (v[j].x * v[j].x + v[j].y * v[j].y) + (v[j].z * v[j].z + v[j].w * v[j].w); }
        const float rstd = rsqrtf(wave_sum(ss) * (1.f / D) + EPS);
        const f32x4* gp = (const f32x4*)gamma + F.lane; const f32x4* scp = (const f32x4*)(modl + bidx * 12288 + sc_off) + F.lane; const f32x4* shp = (const f32x4*)(modl + bidx * 12288 + sh_off) + F.lane;
        u32x2* o8 = (u32x2*)((bf16_t*)H + (size_t)drow * D) + F.lane; unsigned* o4 = (unsigned*)((unsigned char*)H + (size_t)drow * D) + F.lane;
#pragma unroll
        for (int j = 0; j < 8; ++j) {
            const f32x4 g = gp[64 * j], sc = scp[64 * j], sh = shp[64 * j];
            const f32x4 y = v[j] * rstd * g * (sc + 1.f) + sh;
            if constexpr (OUT8) o4[64 * j] = pack4_fp8(y.x * S8_H, y.y * S8_H, y.z * S8_H, y.w * S8_H);
            else { u32x2 w; w.x = cvt_pk_bf16(y.x, y.y); w.y = cvt_pk_bf16(y.z, y.w); o8[64 * j] = w; }
        }
    }
}

constexpr int NBC_FFN = FF2 / 512, NBC_IN1 = (IN1 + 511) / 512, NB_UNITS = 8 * (NBC_FFN + NBC_IN1);
DI void phase_bias(Frame& F) {
    LAS float* cact = (LAS float*)F.lds;
    LAS float* red = (LAS float*)(F.lds + 8192);
    for (int u = F.G - 1 - F.bid; u < NB_UNITS; u += F.G) {
        const int kind = u >= 8 * NBC_FFN ? 1 : 0, uu = kind ? u - 8 * NBC_FFN : u, cb = uu >> 3, kb = uu & 7;
        __syncthreads();
        { const float* mv = WSP(float, WS_MOD) + (kind ? 5 * 12288 : 6144) + kb * 256;
#pragma unroll
          for (int j = 0; j < 3; ++j) { const int i = F.tid + 512 * j; if (i < 5 * 256) cact[i] = mv[(i >> 8) * 12288 + (i & 255)]; } }
        __syncthreads();
        const int N = kind ? IN1 : FF2, ldo = kind ? IN1P : FF2;
        const float* W = F.in[kind ? I1_WIN : I0_FWI]; float* PB = WSP(float, WS_BIASP) + (kind ? (size_t)8 * 5 * FF2 : 0) + (size_t)kb * 5 * ldo;
        const int cg = F.tid & 127, ks = F.tid >> 7;
        const int col = cb * 512 + cg * 4;
        float acc[5][4];
#pragma unroll
        for (int r = 0; r < 5; ++r)
#pragma unroll
            for (int q = 0; q < 4; ++q) acc[r][q] = 0.f;
        if (col < N) {
            const float* wp = W + (size_t)(kb * 256 + ks * 64) * N + col;
            for (int k0 = 0; k0 < 64; k0 += 16) {
                f32x4 w[16];
#pragma unroll
                for (int k = 0; k < 16; ++k) w[k] = __builtin_nontemporal_load((const f32x4*)(wp + (size_t)(k0 + k) * N));
#pragma unroll
                for (int k = 0; k < 16; ++k)
#pragma unroll
                    for (int r = 0; r < 5; ++r) { const float a = cact[r * 256 + ks * 64 + k0 + k]; acc[r][0] += a * w[k][0]; acc[r][1] += a * w[k][1]; acc[r][2] += a * w[k][2]; acc[r][3] += a * w[k][3]; }
            }
        }
#pragma unroll
        for (int r = 0; r < 5; ++r) *(LAS f32x4*)(red + (ks * 5 + r) * 512 + cg * 4) = (f32x4){acc[r][0], acc[r][1], acc[r][2], acc[r][3]};
        __syncthreads();
#pragma unroll
        for (int j = 0; j < 5; ++j) { const int i = F.tid + 512 * j, r = i >> 9, c = i & 511;
            const float sm = (red[(0 * 5 + r) * 512 + c] + red[(1 * 5 + r) * 512 + c]) + (red[(2 * 5 + r) * 512 + c] + red[(3 * 5 + r) * 512 + c]);
            if (cb * 512 + c < N) PB[r * ldo + cb * 512 + c] = sm; }
    }
    __syncthreads();
}
DI void phase_bias_reduce(Frame& F) {
    const float* P2 = WSP(float, WS_BIASP); const float* P1 = P2 + (size_t)8 * 5 * FF2;
    for (int i = F.bid * 512 + F.tid; i < 5 * FF2 + 5 * IN1P; i += F.G * 512) {
        if (i < 5 * FF2) { float sm = 0.f;
#pragma unroll
            for (int kb = 0; kb < 8; ++kb) sm += P2[(size_t)kb * 5 * FF2 + i];
            WSP(float, WS_BIAS2)[i] = sm; }
        else { const int j = i - 5 * FF2, c = j % IN1P; float sm = 0.f;
            if (c < IN1) {
#pragma unroll
                for (int kb = 0; kb < 8; ++kb) sm += P1[(size_t)kb * 5 * IN1P + j]; }
            WSP(float, WS_BIAS1)[j] = sm; }
    }
}

DI void phase_conv(Frame& F) {
    const bf16_t* P = WSP(bf16_t, A_PROJ);
    const int gw = F.bid * 8 + F.wave, NGW = F.G * 8;
    for (int u = gw; u < (NT / 16) * 4; u += NGW) {
        const int run = u >> 2, part = u & 3, isb = part >> 1, half = part & 1;
        const int R0 = run * 16;
        int seq0, seqlen; if (R0 < NL) { seq0 = R0 & ~8191; seqlen = T; } else { seq0 = NL + ((R0 - NL) & ~255); seqlen = TC; }
        const int t0 = R0 - seq0;
        const int ch = half * 512 + F.lane * 8;
        const int pcol = (isb ? 2048 : 0) + ch;
        const float* cw = F.in[isb ? I0_BCW : I0_ACW]; const float* cb = F.in[isb ? I0_BCB : I0_ACB];
        float w0[8], w1[8], w2[8], w3[8], bb[8];
#pragma unroll
        for (int q = 0; q < 8; ++q) { w0[q] = cw[ch + q]; w1[q] = cw[1024 + ch + q]; w2[q] = cw[2048 + ch + q]; w3[q] = cw[3072 + ch + q]; bb[q] = cb[ch + q]; }
        float xm2[8], xm1[8], x0[8], xp1[8];
#define CONV_LD(t_, f_) do { const int _t = (t_); if (_t < 0 || _t >= seqlen) { _Pragma("unroll") for (int q = 0; q < 8; ++q) f_[q] = 0.f; } \
            else { const u32x4 _w = *(const u32x4*)(P + (size_t)(seq0 + _t) * IN0 + pcol); unpack8(_w, f_); } } while (0)
        CONV_LD(t0 - 2, xm2); CONV_LD(t0 - 1, xm1); CONV_LD(t0, x0);
        bf16_t* O = isb ? WSP(bf16_t, A_XCB) : WSP(bf16_t, A_XCA);
        for (int i = 0; i < 16; ++i) {
            CONV_LD(t0 + i + 1, xp1);
            float y[8];
#pragma unroll
            for (int q = 0; q < 8; ++q) { float v = bb[q] + w0[q] * xm2[q] + w1[q] * xm1[q] + w2[q] * x0[q] + w3[q] * xp1[q]; y[q] = isb ? siluf_(v) : v; }
            *(u32x4*)(O + (size_t)(R0 + i) * 1024 + ch) = pack8(y);
#pragma unroll
            for (int q = 0; q < 8; ++q) { xm2[q] = xm1[q]; xm1[q] = x0[q]; x0[q] = xp1[q]; }
        }
#undef CONV_LD
    }
}

constexpr int RG_SEG = 32, RG_SEGLEN = NSTEP / RG_SEG;
template <int PASS> DI void rg_pass(Frame& F) {
    const int gt = F.bid * 512 + F.tid, GT = F.G * 512;
    float* SEGP = WSP(float, A_SEG); float* SEGH = SEGP + 8 * RG_SEG * 1024;
    for (int item = gt; item < 2 * 4 * RG_SEG * 512; item += GT) {
        const int cp = item & 511, seg = (item >> 9) & (RG_SEG - 1), b = (item >> 14) & 3, d = item >> 16, c = cp * 2;
        const bf16_t* RG = WSP(bf16_t, A_RG) + (size_t)d * NT * 1024; const bf16_t* IX = WSP(bf16_t, A_IX) + (size_t)d * NT * 1024;
        bf16_t* HA = WSP(bf16_t, A_HA) + (size_t)d * NT * 1024;
        const float sp0 = log1pf(expf(-F.in[I0_ALAM][d * 1024 + c])), sp1 = log1pf(expf(-F.in[I0_ALAM][d * 1024 + c + 1]));
        float h0 = 0.f, h1 = 0.f, p0 = 1.f, p1 = 1.f;
        const size_t sbase = (size_t)((d * 4 + b) * RG_SEG) * 1024 + c;
        if (PASS == 2) {
            for (int s2 = 0; s2 < seg; ++s2) { const f32x2 pp = *(const f32x2*)(SEGP + sbase + (size_t)s2 * 1024), hh = *(const f32x2*)(SEGH + sbase + (size_t)s2 * 1024); h0 = pp.x * h0 + hh.x; h1 = pp.y * h1 + hh.y; }
        }
        for (int j0 = seg * RG_SEGLEN; j0 < (seg + 1) * RG_SEGLEN; j0 += 12) {
            unsigned r[12], x[12]; int rows[12];
#pragma unroll
            for (int q = 0; q < 12; ++q) { rows[q] = chain_row(d, b, j0 + q); r[q] = *(const unsigned*)(RG + (size_t)rows[q] * 1024 + c); x[q] = *(const unsigned*)(IX + (size_t)rows[q] * 1024 + c); }
#pragma unroll
            for (int q = 0; q < 12; ++q) {
                const float la0 = -8.f * bf2f(r[q] & 0xffffu) * sp0, la1 = -8.f * bf2f(r[q] >> 16) * sp1;
                const float a0 = __expf(la0), a1 = __expf(la1);
                const float b0 = __builtin_amdgcn_sqrtf(fmaxf(1.f - a0 * a0, 0.f)) * bf2f(x[q] & 0xffffu), b1 = __builtin_amdgcn_sqrtf(fmaxf(1.f - a1 * a1, 0.f)) * bf2f(x[q] >> 16);
                h0 = a0 * h0 + b0; h1 = a1 * h1 + b1;
                if (PASS == 1) { p0 *= a0; p1 *= a1; }
                else *(unsigned*)(HA + (size_t)rows[q] * 1024 + c) = cvt_pk_bf16(h0, h1);
            }
        }
        if (PASS == 1) { *(f32x2*)(SEGP + sbase + (size_t)seg * 1024) = (f32x2){p0, p1}; *(f32x2*)(SEGH + sbase + (size_t)seg * 1024) = (f32x2){h0, h1}; }
    }
}

template <int KIND> struct CK {
    static constexpr int DK = KIND == 0 ? 256 : 128;
    static constexpr int DVT = KIND == 0 ? 17 : 16;
    static constexpr int DVP = DVT * 16;
    static constexpr int QLD = DK + 8;
    static constexpr int VLD = DVP + 8;
    static constexpr size_t SLOT = (size_t)DVP * DK;
    static constexpr int IMG = KIND == 0 ? 1024 : 44032;
};
constexpr int TLD = 72;
constexpr int NCHUNK = NSTEP / 64;
struct ChunkLds {
    static constexpr int ROWS = 0, AF = 256, LIF = 512, BA2 = 1024  , W2 = 2048  , TAB = 10240  ;
};
template <int KIND> DI const bf16_t* src_q(Frame& F, int row, int h) { return KIND == 0 ? WSP(bf16_t, A_Q0) + (size_t)row * 1024 + h * 256 : WSP(bf16_t, A_PROJ) + (size_t)row * IN1P + 512 + h * 128; }
template <int KIND> DI const bf16_t* src_k(Frame& F, int row, int h) { return KIND == 0 ? WSP(bf16_t, A_K0) + (size_t)row * 1024 + h * 256 : WSP(bf16_t, A_PROJ) + (size_t)row * IN1P + 1024 + h * 128; }
template <int KIND> DI const bf16_t* src_v(Frame& F, int row, int h) { return KIND == 0 ? WSP(bf16_t, A_V0) + (size_t)row * 1024 + h * 256 : WSP(bf16_t, A_PROJ) + (size_t)row * IN1P + 1536 + h * 256; }
DI void gla_bcum8(Frame& F, int cg, const float (&alr)[16], float (&bc)[8]) {
    const LAS float* w2 = (const LAS float*)(F.lds + ChunkLds::W2) + cg * 8; const LAS float* ba = (const LAS float*)(F.lds + ChunkLds::BA2) + cg * 8;
#pragma unroll
    for (int i0 = 0; i0 < 8; i0 += 4) {
#pragma unroll
        for (int i = i0; i < i0 + 4; ++i) { float z = ba[i];
#pragma unroll
            for (int r = 0; r < 16; ++r) z += alr[r] * w2[r * 128 + i];
            bc[i] = wave_scan(log_sigmoidf_(z) * (1.f / 16.f), F.lane); }
        asm volatile("" : "+v"(bc[i0]), "+v"(bc[i0 + 1]), "+v"(bc[i0 + 2]), "+v"(bc[i0 + 3]));
    }
}
DI void gla_stage_w2(Frame& F, int d, int h) {
    const float* wa2 = F.in[I1_WA2] + (size_t)d * 16 * 512 + h * 128;
    const int r = F.tid >> 5, c4 = (F.tid & 31) * 4;
    *(LAS f32x4*)((LAS float*)(F.lds + ChunkLds::W2) + r * 128 + c4) = *(const f32x4*)(wa2 + r * 512 + c4);
    if (F.tid < 32) *(LAS f32x4*)((LAS float*)(F.lds + ChunkLds::BA2) + c4) = *(const f32x4*)(F.in[I1_BA2] + d * 512 + h * 128 + c4);
}
DI void load_alr(Frame& F, int row, int d, float (&alr)[16]) {
    const bf16_t* p = WSP(bf16_t, A_PROJ) + (size_t)row * IN1P + 3584 + d * 16; float t0[8], t1[8]; unpack8(*(const u32x4*)p, t0); unpack8(*(const u32x4*)(p + 8), t1);
#pragma unroll
    for (int q = 0; q < 8; ++q) { alr[q] = t0[q]; alr[8 + q] = t1[q]; }
}
typedef short s16x4v __attribute__((ext_vector_type(4)));
DI bf16x8 tr_frag(const LAS bf16_t* img, int ld, int s0, int c0, int lane) {
    const int i = lane & 15; const LAS bf16_t* p = img + (s0 + (i >> 2)) * ld + c0 + 4 * (i & 3);
    const s16x4v lo = __builtin_amdgcn_ds_read_tr16_b64_v4i16((LAS s16x4v*)p), hi = __builtin_amdgcn_ds_read_tr16_b64_v4i16((LAS s16x4v*)(p + 4 * ld));
    return __builtin_shufflevector(lo, hi, 0, 1, 2, 3, 4, 5, 6, 7);
}
constexpr int GTAB_LD = 132;
template <int KIND> struct K1Regs { u32x4 kw[64 * (CK<KIND>::DK / 8) / 512], vw[64 * 32 / 512]; float alr[16]; };
template <int KIND> DI void k1_load(Frame& F, int unit, K1Regs<KIND>& R) {
    typedef CK<KIND> C; constexpr int DK = C::DK, KP = DK / 8, NKI = 64 * KP / 512, NVI = 64 * 32 / 512;
    const int chain = unit / NCHUNK, c = unit % NCHUNK, d = chain >> 4, b = (chain >> 2) & 3, h = chain & 3;
#pragma unroll
    for (int it = 0; it < NKI; ++it) { const int idx = F.tid + 512 * it, sidx = idx / KP, pc = idx % KP; R.kw[it] = *(const u32x4*)(src_k<KIND>(F, chain_row(d, b, c * 64 + sidx), h) + pc * 8); }
#pragma unroll
    for (int it = 0; it < NVI; ++it) { const int idx = F.tid + 512 * it, sidx = idx >> 5, pc = idx & 31; R.vw[it] = *(const u32x4*)(src_v<KIND>(F, chain_row(d, b, c * 64 + sidx), h) + pc * 8); }
    if (KIND == 1) load_alr(F, chain_row(d, b, c * 64 + F.lane), d, R.alr);
}
template <int KIND> DI void chunk_k1(Frame& F, bf16_t* STb, float* GAM, int unit, bool first, K1Regs<KIND>& R, int nxt_unit) {
    typedef CK<KIND> C; constexpr int DK = C::DK, QLD = C::QLD, VLD = C::VLD, NMT = DK / 128, KP = DK / 8  , NKI = 64 * KP / 512, NVI = 64 * 32 / 512;
    const int chain = unit / NCHUNK, c = unit % NCHUNK, d = chain >> 4, b = (chain >> 2) & 3, h = chain & 3;
    const int row = chain_row(d, b, c * 64 + F.lane);
    LAS bf16_t* KS = (LAS bf16_t*)(F.lds + C::IMG); LAS bf16_t* VS = KS + 64 * QLD; LAS float* TAB = (LAS float*)(F.lds + ChunkLds::TAB);
    lds_barrier();
    u32x4 (&kw)[NKI] = R.kw; u32x4 (&vw)[NVI] = R.vw;
    if (KIND == 0) {
        const float* gt = WSP(float, WS_GATES) + (size_t)row * 16 + d * 8;
        const float li = gt[h], a = wave_scan(log_sigmoidf_(gt[4 + h]), F.lane); const float a63 = __shfl(a, 63);
        const float wsc = __expf(a63 - a + li);
#pragma unroll
        for (int it = 0; it < NKI; ++it) { const int idx = F.tid + 512 * it, sidx = idx / KP, pc = idx % KP; const float w = __shfl(wsc, sidx); float v[8]; unpack8(kw[it], v);
#pragma unroll
            for (int i = 0; i < 8; ++i) v[i] *= w;
            *(LAS u32x4*)(KS + sidx * QLD + pc * 8) = pack8(v); }
        if (F.tid == 0) GAM[unit] = __expf(a63);
        if (F.tid < 64) { LAS u32x4* o = (LAS u32x4*)(VS + F.tid * VLD + 256); o[0] = (u32x4){0x3F80u, 0u, 0u, 0u}; o[1] = (u32x4){0u, 0u, 0u, 0u}; }
    } else {
        float (&alr)[16] = R.alr; if (first || c == 0) { gla_stage_w2(F, d, h); lds_barrier(); }
#pragma unroll
        for (int j = 0; j < 2; ++j) { const int cg = F.wave + 8 * j; float bc[8]; gla_bcum8(F, cg, alr, bc); float e[8];
#pragma unroll
            for (int i = 0; i < 8; ++i) { const float b63 = __shfl(bc[i], 63); e[i] = __expf(b63 - bc[i]); if (F.lane == 0) GAM[(size_t)unit * 128 + cg * 8 + i] = __expf(b63); }
            *(LAS f32x4*)(TAB + F.lane * GTAB_LD + cg * 8) = (f32x4){e[0], e[1], e[2], e[3]}; *(LAS f32x4*)(TAB + F.lane * GTAB_LD + cg * 8 + 4) = (f32x4){e[4], e[5], e[6], e[7]}; }
        lds_barrier();
#pragma unroll
        for (int it = 0; it < NKI; ++it) { const int idx = F.tid + 512 * it, sidx = idx / KP, pc = idx % KP; float v[8]; unpack8(kw[it], v);
            const f32x4 e0 = *(const LAS f32x4*)(TAB + sidx * GTAB_LD + pc * 8), e1 = *(const LAS f32x4*)(TAB + sidx * GTAB_LD + pc * 8 + 4);
#pragma unroll
            for (int i = 0; i < 4; ++i) { v[i] *= e0[i]; v[4 + i] *= e1[i]; }
            *(LAS u32x4*)(KS + sidx * QLD + pc * 8) = pack8(v); }
    }
#pragma unroll
    for (int it = 0; it < NVI; ++it) { const int idx = F.tid + 512 * it, sidx = idx >> 5, pc = idx & 31; *(LAS u32x4*)(VS + sidx * VLD + pc * 8) = vw[it]; }
    lds_barrier();
    if (nxt_unit >= 0) k1_load<KIND>(F, nxt_unit, R);
    const int fr = F.lane & 15, fq = F.lane >> 4;
    bf16_t* slot = STb + (size_t)unit * C::SLOT;
    bf16x8 a[NMT][2];
#pragma unroll
    for (int mi = 0; mi < NMT; ++mi)
#pragma unroll
        for (int ks = 0; ks < 2; ++ks) a[mi][ks] = tr_frag(KS, QLD, ks * 32 + 8 * fq, (F.wave + 8 * mi) * 16, F.lane);
#pragma unroll 4
    for (int nt = 0; nt < C::DVT; ++nt) {
        bf16x8 bb[2];
#pragma unroll
        for (int ks = 0; ks < 2; ++ks) bb[ks] = tr_frag(VS, VLD, ks * 32 + 8 * fq, nt * 16, F.lane);
#pragma unroll
        for (int mi = 0; mi < NMT; ++mi) {
            f32x4 acc = (f32x4){0.f, 0.f, 0.f, 0.f};
#pragma unroll
            for (int ks = 0; ks < 2; ++ks) acc = __builtin_amdgcn_mfma_f32_16x16x32_bf16(a[mi][ks], bb[ks], acc, 0, 0, 0);
            u32x2 w; w.x = cvt_pk_bf16(acc[0], acc[1]); w.y = cvt_pk_bf16(acc[2], acc[3]);
            *(u32x2*)(slot + (size_t)(nt * 16 + fr) * DK + (F.wave + 8 * mi) * 16 + 4 * fq) = w;
        }
    }
}
template <int KIND, int NCH = NCHUNK, int UBP = 0> DI void chunk_k2(Frame& F, bf16_t* STb, const float* GAM) {
    typedef CK<KIND> C; constexpr int DK = C::DK; constexpr int PER = (int)(C::SLOT / 8);
    const int gt = F.bid * 512 + F.tid, GT = F.G * 512;
    for (int item = gt; item < 32 * PER; item += GT) {
        const int chain = item / PER, e = item % PER, k0 = (e * 8) % DK;
        float S[8];
#pragma unroll
        for (int i = 0; i < 8; ++i) S[i] = 0.f;
        bf16_t* p = STb + (size_t)chain * NCH * C::SLOT + (size_t)e * 8;
        constexpr int UB = UBP ? UBP : (KIND == 0 ? 12 : 6); static_assert(NCH % UB == 0, "whole batches");
        for (int c0 = 0; c0 < NCH; c0 += UB) {
            u32x4 dv[UB]; float g[UB][KIND == 0 ? 1 : 8];
#pragma unroll
            for (int q = 0; q < UB; ++q) { dv[q] = *(const u32x4*)(p + (size_t)(c0 + q) * C::SLOT);
                if (KIND == 0) g[q][0] = GAM[chain * NCH + c0 + q];
                else { const float* gp = GAM + ((size_t)(chain * NCH + c0 + q)) * 128 + k0; const f32x4 g0 = *(const f32x4*)gp, g1 = *(const f32x4*)(gp + 4);
                    g[q][0] = g0[0]; g[q][1] = g0[1]; g[q][2] = g0[2]; g[q][3] = g0[3]; g[q][4] = g1[0]; g[q][5] = g1[1]; g[q][6] = g1[2]; g[q][7] = g1[3]; } }
#pragma unroll
            for (int q = 0; q < UB; ++q) {
                float dl[8]; unpack8(dv[q], dl);
                *(u32x4*)(p + (size_t)(c0 + q) * C::SLOT) = pack8(S);
#pragma unroll
                for (int i = 0; i < 8; ++i) S[i] = g[q][KIND == 0 ? 0 : i] * S[i] + dl[i];
            }
        }
    }
}
template <int KIND> struct K3Regs { u32x4 qw[64 * (CK<KIND>::DK / 8) / 512], kw[64 * (CK<KIND>::DK / 8) / 512], vw[64 * 32 / 512]; float alr[16]; };
template <int KIND> DI void k3_load(Frame& F, int unit, K3Regs<KIND>& R) {
    typedef CK<KIND> C; constexpr int DK = C::DK, KP = DK / 8, NKI = 64 * KP / 512, NVI = 64 * 32 / 512;
    const int chain = unit / NCHUNK, c = unit % NCHUNK, d = chain >> 4, b = (chain >> 2) & 3, h = chain & 3;
#pragma unroll
    for (int it = 0; it < NKI; ++it) { const int idx = F.tid + 512 * it, sidx = idx / KP, pc = idx % KP; const int rw = chain_row(d, b, c * 64 + sidx);
        R.qw[it] = *(const u32x4*)(src_q<KIND>(F, rw, h) + pc * 8); R.kw[it] = *(const u32x4*)(src_k<KIND>(F, rw, h) + pc * 8); }
#pragma unroll
    for (int it = 0; it < NVI; ++it) { const int idx = F.tid + 512 * it, sidx = idx >> 5, pc = idx & 31; R.vw[it] = *(const u32x4*)(src_v<KIND>(F, chain_row(d, b, c * 64 + sidx), h) + pc * 8); }
    if (KIND == 1) load_alr(F, chain_row(d, b, c * 64 + F.lane), d, R.alr);
}
template <int KIND> DI void chunk_k3(Frame& F, const bf16_t* STb, bf16_t* OUT, int unit, bool first, K3Regs<KIND>& R, int nxt_unit) {
    typedef CK<KIND> C; constexpr int DK = C::DK, QLD = C::QLD, VLD = C::VLD, NKS = DK / 32, KP = DK / 8, NKI = 64 * KP / 512, NVI = 64 * 32 / 512;
    static_assert(C::IMG + (2 * 64 * QLD + 64 * VLD + 64 * TLD) * 2 <= RING_BYTES, "chunk images fit the ring");
    const int chain = unit / NCHUNK, c = unit % NCHUNK, d = chain >> 4, b = (chain >> 2) & 3, h = chain & 3;
    const int row = chain_row(d, b, c * 64 + F.lane);
    LAS int* rows = (LAS int*)(F.lds + ChunkLds::ROWS); LAS float* af = (LAS float*)(F.lds + ChunkLds::AF); LAS float* lif = (LAS float*)(F.lds + ChunkLds::LIF); LAS float* TAB = (LAS float*)(F.lds + ChunkLds::TAB);
    LAS bf16_t* QS = (LAS bf16_t*)(F.lds + C::IMG); LAS bf16_t* KS = QS + 64 * QLD; LAS bf16_t* VS = KS + 64 * QLD; LAS bf16_t* PS = VS + 64 * VLD;
    lds_barrier();
    const int fr = F.lane & 15, fq = F.lane >> 4;
    const bf16_t* slot = STb + (size_t)unit * C::SLOT;
    bf16x8 sb[2][NKS], sn[NKS];
#pragma unroll
    for (int j = 0; j < 2; ++j)
#pragma unroll
        for (int ks = 0; ks < NKS; ++ks) sb[j][ks] = *(const bf16x8*)(slot + (size_t)((F.wave + 8 * j) * 16 + fr) * DK + ks * 32 + fq * 8);
    if (KIND == 0) {
#pragma unroll
        for (int ks = 0; ks < NKS; ++ks) { sn[ks] = (bf16x8){0, 0, 0, 0, 0, 0, 0, 0}; if (fr == 0) sn[ks] = *(const bf16x8*)(slot + (size_t)256 * DK + ks * 32 + fq * 8); }
    }
    {
        u32x4 (&qw)[NKI] = R.qw; u32x4 (&kw)[NKI] = R.kw; u32x4 (&vw)[NVI] = R.vw;
        if (KIND == 0) {
            if (F.wave == 0) { const float* gt = WSP(float, WS_GATES) + (size_t)row * 16 + d * 8; lif[F.lane] = gt[h]; af[F.lane] = wave_scan(log_sigmoidf_(gt[4 + h]), F.lane); rows[F.lane] = row; }
            if (F.tid < 64) { LAS u32x4* o = (LAS u32x4*)(VS + F.tid * VLD + 256); o[0] = (u32x4){0x3F80u, 0u, 0u, 0u}; o[1] = (u32x4){0u, 0u, 0u, 0u}; }
        } else {
            if (F.wave == 0) rows[F.lane] = row;
            float (&alr)[16] = R.alr; if (first || c == 0) { gla_stage_w2(F, d, h); lds_barrier(); }
#pragma unroll
            for (int j = 0; j < 2; ++j) { const int cg = F.wave + 8 * j; float bc[8]; gla_bcum8(F, cg, alr, bc);
                *(LAS f32x4*)(TAB + F.lane * GTAB_LD + cg * 8) = (f32x4){bc[0], bc[1], bc[2], bc[3]}; *(LAS f32x4*)(TAB + F.lane * GTAB_LD + cg * 8 + 4) = (f32x4){bc[4], bc[5], bc[6], bc[7]}; }
            lds_barrier();
#pragma unroll
            for (int it = 0; it < NKI; ++it) { const int idx = F.tid + 512 * it, sidx = idx / KP, pc = idx % KP; float q[8], k[8]; unpack8(qw[it], q); unpack8(kw[it], k);
                const f32x4 b0 = *(const LAS f32x4*)(TAB + sidx * GTAB_LD + pc * 8), b1 = *(const LAS f32x4*)(TAB + sidx * GTAB_LD + pc * 8 + 4);
#pragma unroll
                for (int i = 0; i < 4; ++i) { q[i] *= __expf(b0[i]) * 0.08838834764831845f; k[i] *= __expf(-b0[i]); q[4 + i] *= __expf(b1[i]) * 0.08838834764831845f; k[4 + i] *= __expf(-b1[i]); }
                qw[it] = pack8(q); kw[it] = pack8(k); }
        }
#pragma unroll
        for (int it = 0; it < NKI; ++it) { const int idx = F.tid + 512 * it, sidx = idx / KP, pc = idx % KP; *(LAS u32x4*)(QS + sidx * QLD + pc * 8) = qw[it]; *(LAS u32x4*)(KS + sidx * QLD + pc * 8) = kw[it]; }
#pragma unroll
        for (int it = 0; it < NVI; ++it) { const int idx = F.tid + 512 * it, sidx = idx >> 5, pc = idx & 31; *(LAS u32x4*)(VS + sidx * VLD + pc * 8) = vw[it]; }
        for (int i = F.tid; i < 64 * TLD / 2; i += 512) ((LAS unsigned*)PS)[i] = 0u;
    }
    lds_barrier();
    if (nxt_unit >= 0) k3_load<KIND>(F, nxt_unit, R);
    {
        for (int tl = F.wave; tl < 10; tl += 8) {
            int ti = 0, si = tl; while (si > ti) { si -= ti + 1; ++ti; }
            f32x4 acc = (f32x4){0.f, 0.f, 0.f, 0.f};
#pragma unroll
            for (int ks = 0; ks < NKS; ++ks) { const bf16x8 a = *(const LAS bf16x8*)(KS + (si * 16 + fr) * QLD + ks * 32 + fq * 8), bb = *(const LAS bf16x8*)(QS + (ti * 16 + fr) * QLD + ks * 32 + fq * 8);
                acc = __builtin_amdgcn_mfma_f32_16x16x32_bf16(a, bb, acc, 0, 0, 0); }
            const int t = ti * 16 + fr; float o[4];
#pragma unroll
            for (int r = 0; r < 4; ++r) { const int sidx = si * 16 + 4 * fq + r; float v = acc[r];
                if (KIND == 0) v *= __expf(af[t] - af[sidx] + lif[sidx]);
                o[r] = sidx <= t ? v : 0.f; }
            u32x2 w; w.x = cvt_pk_bf16(o[0], o[1]); w.y = cvt_pk_bf16(o[2], o[3]);
            *(LAS u32x2*)(PS + t * TLD + si * 16 + 4 * fq) = w;
        }
    }
    lds_barrier();
    {
        bf16x8 vb[2][2];
#pragma unroll
        for (int j = 0; j < 2; ++j)
#pragma unroll
            for (int ks = 0; ks < 2; ++ks) vb[j][ks] = tr_frag(VS, VLD, ks * 32 + 8 * fq, (F.wave + 8 * j) * 16, F.lane);
#pragma unroll 1
        for (int ti = 0; ti < 4; ++ti) {
            bf16x8 pa[2], qa[NKS];
#pragma unroll
            for (int ks = 0; ks < 2; ++ks) pa[ks] = *(const LAS bf16x8*)(PS + (ti * 16 + fr) * TLD + ks * 32 + fq * 8);
#pragma unroll
            for (int ks = 0; ks < NKS; ++ks) qa[ks] = *(const LAS bf16x8*)(QS + (ti * 16 + fr) * QLD + ks * 32 + fq * 8);
            float wt[4], rden[4]; int orow[4];
#pragma unroll
            for (int r = 0; r < 4; ++r) { const int t = ti * 16 + 4 * fq + r; wt[r] = KIND == 0 ? __expf(af[t]) : 1.f; orow[r] = rows[t]; rden[r] = 1.f; }
            if (KIND == 0) {
                f32x4 aP = (f32x4){0.f, 0.f, 0.f, 0.f}, aQ = (f32x4){0.f, 0.f, 0.f, 0.f};
#pragma unroll
                for (int ks = 0; ks < 2; ++ks) { const bf16x8 bb = tr_frag(VS, VLD, ks * 32 + 8 * fq, 256, F.lane); aP = __builtin_amdgcn_mfma_f32_16x16x32_bf16(pa[ks], bb, aP, 0, 0, 0); }
#pragma unroll
                for (int ks = 0; ks < NKS; ++ks) aQ = __builtin_amdgcn_mfma_f32_16x16x32_bf16(qa[ks], sn[ks], aQ, 0, 0, 0);
#pragma unroll
                for (int r = 0; r < 4; ++r) { const float den = aP[r] + wt[r] * aQ[r]; const float dd = __shfl(den, F.lane & 48); rden[r] = 1.f / fmaxf(fabsf(dd), 1.f); }
            }
#pragma unroll
            for (int j = 0; j < 2; ++j) {
                f32x4 aP = (f32x4){0.f, 0.f, 0.f, 0.f}, aQ = (f32x4){0.f, 0.f, 0.f, 0.f};
#pragma unroll
                for (int ks = 0; ks < 2; ++ks) aP = __builtin_amdgcn_mfma_f32_16x16x32_bf16(pa[ks], vb[j][ks], aP, 0, 0, 0);
#pragma unroll
                for (int ks = 0; ks < NKS; ++ks) aQ = __builtin_amdgcn_mfma_f32_16x16x32_bf16(qa[ks], sb[j][ks], aQ, 0, 0, 0);
                const int col = h * 256 + (F.wave + 8 * j) * 16 + fr;
#pragma unroll
                for (int r = 0; r < 4; ++r) {
                    const float o = (aP[r] + wt[r] * aQ[r]) * rden[r];
                    if (KIND == 0) OUT[(size_t)orow[r] * 1024 + col] = f2bf(o);
                    else if (orow[r] < NL) OUT[(size_t)orow[r] * 1024 + col] = f2bf(o);
                }
            }
        }
    }
}
DI void unit_range(Frame& F, int& u0, int& u1) { const int n = 32 * NCHUNK; const long a = (long)n * F.bid / F.G, b = (long)n * (F.bid + 1) / F.G; u0 = (int)a; u1 = (int)b; }
template <int KIND> DI void phase_k1(Frame& F) { bf16_t* ST = WSP(bf16_t, A_ST); float* GAM = WSP(float, A_GAM); int u0, u1; unit_range(F, u0, u1); K1Regs<KIND> R; if (u0 < u1) k1_load<KIND>(F, u0, R);
    for (int u = u0; u < u1; ++u) chunk_k1<KIND>(F, ST, GAM, u, u == u0, R, u + 1 < u1 ? u + 1 : -1); __syncthreads(); }
template <int KIND> DI void phase_k3(Frame& F, bf16_t* OUTB, size_t dir_stride) {
    const bf16_t* ST = WSP(bf16_t, A_ST);
    int u0, u1; unit_range(F, u0, u1);
    K3Regs<KIND> R; if (u0 < u1) k3_load<KIND>(F, u0, R);
    for (int u = u0; u < u1; ++u) { const int d = (u / NCHUNK) >> 4; chunk_k3<KIND>(F, ST, OUTB + (size_t)d * dir_stride, u, u == u0, R, u + 1 < u1 ? u + 1 : -1); }
    __syncthreads();
}

constexpr int SG = 4, NSUP = NCHUNK / SG;
struct MlLds { static constexpr int ROWS = 0, TOT = 256, AFT = 1024  , LIT = 2048  , IMG = 4096; };
struct MK1Regs { u32x4 kw[2], vw[4]; float gl[SG], gf[SG]; };
DI void mk1_load_blk(Frame& F, int unit, int j, MK1Regs& R) {
    const int chain = unit / (2 * NSUP), rem = unit % (2 * NSUP), sg = rem >> 1, kh = rem & 1, d = chain >> 4, b = (chain >> 2) & 3, h = chain & 3;
    const int c = sg * SG + j;
#pragma unroll
    for (int it = 0; it < 2; ++it) { const int idx = F.tid + 512 * it, sidx = idx >> 4, pc = idx & 15; R.kw[it] = *(const u32x4*)(src_k<0>(F, chain_row(d, b, c * 64 + sidx), h) + kh * 128 + pc * 8); }
#pragma unroll
    for (int it = 0; it < 4; ++it) { const int idx = F.tid + 512 * it, sidx = idx >> 5, pc = idx & 31; R.vw[it] = *(const u32x4*)(src_v<0>(F, chain_row(d, b, c * 64 + sidx), h) + pc * 8); }
}
DI void mk1_load_gates(Frame& F, int unit, MK1Regs& R) {
    const int chain = unit / (2 * NSUP), rem = unit % (2 * NSUP), sg = rem >> 1, d = chain >> 4, b = (chain >> 2) & 3, h = chain & 3;
#pragma unroll
    for (int j = 0; j < SG; ++j) { const int row = chain_row(d, b, (sg * SG + j) * 64 + F.lane); const float* gt = WSP(float, WS_GATES) + (size_t)row * 16 + d * 8; R.gl[j] = gt[h]; R.gf[j] = gt[4 + h]; }
}
DI void ml_k1(Frame& F, bf16_t* STb, float* GAM, int unit, MK1Regs& R, int nxt_unit) {
    constexpr int DK = 256, KLD = 128 + 8, VLD = 280;
    const int chain = unit / (2 * NSUP), rem = unit % (2 * NSUP), sg = rem >> 1, kh = rem & 1;
    LAS bf16_t* KS = (LAS bf16_t*)(F.lds + MlLds::IMG); LAS bf16_t* VS = KS + 64 * KLD;
    float lw[SG], tot[SG];
#pragma unroll
    for (int j = 0; j < SG; ++j) { const float li = R.gl[j], a = wave_scan(log_sigmoidf_(R.gf[j]), F.lane); tot[j] = __shfl(a, 63); lw[j] = tot[j] - a + li; }
    { float tail = 0.f;
#pragma unroll
      for (int j = SG - 1; j >= 0; --j) { lw[j] = __expf(lw[j] + tail); tail += tot[j]; }
      if (kh == 0 && F.tid == 0) GAM[chain * NSUP + sg] = __expf(tail); }
    const int fr = F.lane & 15, fq = F.lane >> 4;
    f32x4 acc[17];
#pragma unroll
    for (int nt = 0; nt < 17; ++nt) acc[nt] = (f32x4){0.f, 0.f, 0.f, 0.f};
#pragma unroll
    for (int j = 0; j < SG; ++j) {
        lds_barrier();
#pragma unroll
        for (int it = 0; it < 2; ++it) { const int idx = F.tid + 512 * it, sidx = idx >> 4, pc = idx & 15; const float w = __shfl(lw[j], sidx); float v[8]; unpack8(R.kw[it], v);
#pragma unroll
            for (int i = 0; i < 8; ++i) v[i] *= w;
            *(LAS u32x4*)(KS + sidx * KLD + pc * 8) = pack8(v); }
#pragma unroll
        for (int it = 0; it < 4; ++it) { const int idx = F.tid + 512 * it, sidx = idx >> 5, pc = idx & 31; *(LAS u32x4*)(VS + sidx * VLD + pc * 8) = R.vw[it]; }
        if (F.tid < 64) { LAS u32x4* o = (LAS u32x4*)(VS + F.tid * VLD + 256); o[0] = (u32x4){0x3F80u, 0u, 0u, 0u}; o[1] = (u32x4){0u, 0u, 0u, 0u}; }
        lds_barrier();
        if (j + 1 < SG) mk1_load_blk(F, unit, j + 1, R);
        else if (nxt_unit >= 0) { mk1_load_gates(F, nxt_unit, R); mk1_load_blk(F, nxt_unit, 0, R); }
        bf16x8 a[2];
#pragma unroll
        for (int ks = 0; ks < 2; ++ks) a[ks] = tr_frag(KS, KLD, ks * 32 + 8 * fq, F.wave * 16, F.lane);
#pragma unroll
        for (int nt = 0; nt < 17; ++nt) {
#pragma unroll
            for (int ks = 0; ks < 2; ++ks) acc[nt] = __builtin_amdgcn_mfma_f32_16x16x32_bf16(a[ks], tr_frag(VS, VLD, ks * 32 + 8 * fq, nt * 16, F.lane), acc[nt], 0, 0, 0);
        }
    }
    bf16_t* slot = STb + (size_t)(chain * NSUP + sg) * CK<0>::SLOT;
#pragma unroll
    for (int nt = 0; nt < 17; ++nt) { u32x2 w; w.x = cvt_pk_bf16(acc[nt][0], acc[nt][1]); w.y = cvt_pk_bf16(acc[nt][2], acc[nt][3]);
        *(u32x2*)(slot + (size_t)(nt * 16 + fr) * DK + kh * 128 + F.wave * 16 + 4 * fq) = w; }
}
DI void ml_k3(Frame& F, const bf16_t* STb, bf16_t* OUT, int unit) {
    constexpr int DK = 256, QLD = 264, VLD = 280, NKS = 8;
    static_assert(MlLds::IMG + (2 * 64 * QLD + 64 * VLD + 64 * TLD + 16 * QLD) * 2 <= RING_BYTES, "mLSTM chunk images fit the ring");
    const int chain = unit / NCHUNK, c = unit % NCHUNK, sg = c / SG, jq = c % SG, d = chain >> 4, b = (chain >> 2) & 3, h = chain & 3;
    LAS int* rows = (LAS int*)(F.lds + MlLds::ROWS); LAS float* totl = (LAS float*)(F.lds + MlLds::TOT); LAS float* AFT = (LAS float*)(F.lds + MlLds::AFT); LAS float* LIT = (LAS float*)(F.lds + MlLds::LIT);
    LAS bf16_t* QS = (LAS bf16_t*)(F.lds + MlLds::IMG); LAS bf16_t* KS = QS + 64 * QLD; LAS bf16_t* VS = KS + 64 * QLD; LAS bf16_t* PS = VS + 64 * VLD; LAS bf16_t* NS = PS + 64 * TLD;
    lds_barrier();
    const int fr = F.lane & 15, fq = F.lane >> 4;
    const bf16_t* slot = STb + (size_t)(chain * NSUP + sg) * CK<0>::SLOT;
    u32x4 kw[4], vw[4];
#define ML_LOAD_KV(kb_) do { const int _ck = sg * SG + (kb_); _Pragma("unroll") for (int it = 0; it < 4; ++it) { const int idx = F.tid + 512 * it, sidx = idx >> 5, pc = idx & 31; const int rw = chain_row(d, b, _ck * 64 + sidx); \
        kw[it] = *(const u32x4*)(src_k<0>(F, rw, h) + pc * 8); vw[it] = *(const u32x4*)(src_v<0>(F, rw, h) + pc * 8); } } while (0)
    ML_LOAD_KV(0);
    {
        u32x4 qw[4];
#pragma unroll
        for (int it = 0; it < 4; ++it) { const int idx = F.tid + 512 * it, sidx = idx >> 5, pc = idx & 31; qw[it] = *(const u32x4*)(src_q<0>(F, chain_row(d, b, c * 64 + sidx), h) + pc * 8); }
        if (F.wave <= jq) { const int row = chain_row(d, b, (sg * SG + F.wave) * 64 + F.lane); const float* gt = WSP(float, WS_GATES) + (size_t)row * 16 + d * 8;
            const float a = wave_scan(log_sigmoidf_(gt[4 + h]), F.lane); LIT[F.wave * 64 + F.lane] = gt[h]; AFT[F.wave * 64 + F.lane] = a; if (F.lane == 63) totl[F.wave] = a; if (F.wave == jq) rows[F.lane] = row; }
#pragma unroll
        for (int it = 0; it < 4; ++it) { const int idx = F.tid + 512 * it, sidx = idx >> 5, pc = idx & 31; *(LAS u32x4*)(QS + sidx * QLD + pc * 8) = qw[it]; }
        for (int i = F.tid; i < 15 * QLD / 8; i += 512) ((LAS u32x4*)(NS + QLD))[i] = (u32x4){0u, 0u, 0u, 0u};
    }
    f32x4 accP[4][3];
#pragma unroll
    for (int ti = 0; ti < 4; ++ti)
#pragma unroll
        for (int jt = 0; jt < 3; ++jt) accP[ti][jt] = (f32x4){0.f, 0.f, 0.f, 0.f};
    float offq = 0.f, offk = 0.f;
#define ML_STAGE_KV() do { _Pragma("unroll") for (int it = 0; it < 4; ++it) { const int idx = F.tid + 512 * it, sidx = idx >> 5, pc = idx & 31; *(LAS u32x4*)(KS + sidx * QLD + pc * 8) = kw[it]; *(LAS u32x4*)(VS + sidx * VLD + pc * 8) = vw[it]; } \
        if (F.tid < 64) { LAS u32x4* o = (LAS u32x4*)(VS + F.tid * VLD + 256); o[0] = (u32x4){0x3F80u, 0u, 0u, 0u}; o[1] = (u32x4){0u, 0u, 0u, 0u}; } } while (0)
#define ML_P_AND_PV(kb_, DIAG) do { \
        _Pragma("unroll") for (int tq = 0; tq < 2; ++tq) { const int tl = F.wave + 8 * tq, ti = tl >> 2, si = tl & 3; f32x4 acc = (f32x4){0.f, 0.f, 0.f, 0.f}; \
            if (!((DIAG) && si > ti)) { _Pragma("unroll") for (int ks = 0; ks < NKS; ++ks) { const bf16x8 a = *(const LAS bf16x8*)(KS + (si * 16 + fr) * QLD + ks * 32 + fq * 8), bb = *(const LAS bf16x8*)(QS + (ti * 16 + fr) * QLD + ks * 32 + fq * 8); \
                acc = __builtin_amdgcn_mfma_f32_16x16x32_bf16(a, bb, acc, 0, 0, 0); } } \
            const int t = ti * 16 + fr; const float at = offq + AFT[jq * 64 + t]; float o[4]; \
            _Pragma("unroll") for (int r = 0; r < 4; ++r) { const int sidx = si * 16 + 4 * fq + r; const float v = acc[r] * __expf(at - (offk + AFT[(kb_) * 64 + sidx]) + LIT[(kb_) * 64 + sidx]); o[r] = (!(DIAG) || sidx <= t) ? v : 0.f; } \
            u32x2 w; w.x = cvt_pk_bf16(o[0], o[1]); w.y = cvt_pk_bf16(o[2], o[3]); *(LAS u32x2*)(PS + t * TLD + si * 16 + 4 * fq) = w; } \
        lds_barrier(); \
        _Pragma("unroll") for (int ti = 0; ti < 4; ++ti) { bf16x8 pa[2]; \
            _Pragma("unroll") for (int ks = 0; ks < 2; ++ks) pa[ks] = *(const LAS bf16x8*)(PS + (ti * 16 + fr) * TLD + ks * 32 + fq * 8); \
            _Pragma("unroll") for (int jt = 0; jt < 3; ++jt) { const int c0 = jt < 2 ? (F.wave + 8 * jt) * 16 : 256; \
                _Pragma("unroll") for (int ks = 0; ks < 2; ++ks) accP[ti][jt] = __builtin_amdgcn_mfma_f32_16x16x32_bf16(pa[ks], tr_frag(VS, VLD, ks * 32 + 8 * fq, c0, F.lane), accP[ti][jt], 0, 0, 0); } } } while (0)
    for (int kb = 0; kb < jq; ++kb) {
        ML_STAGE_KV();
        lds_barrier();
        if (kb == 0) { for (int i = 0; i < jq; ++i) offq += totl[i]; }
        ML_LOAD_KV(kb + 1);
        ML_P_AND_PV(kb, false);
        offk += totl[kb];
        lds_barrier();
    }
    bf16x8 sb[2][NKS];
#pragma unroll
    for (int j = 0; j < 2; ++j)
#pragma unroll
        for (int ks = 0; ks < NKS; ++ks) sb[j][ks] = *(const bf16x8*)(slot + (size_t)((F.wave + 8 * j) * 16 + fr) * DK + ks * 32 + fq * 8);
    if (F.tid < DK / 8) *(LAS u32x4*)(NS + F.tid * 8) = *(const u32x4*)(slot + (size_t)256 * DK + F.tid * 8);
    ML_STAGE_KV();
    lds_barrier();
    if (jq == 0) offq = 0.f;
    ML_P_AND_PV(jq, true);
    lds_barrier();
#undef ML_LOAD_KV
#undef ML_STAGE_KV
#undef ML_P_AND_PV
#pragma unroll
    for (int ti = 0; ti < 4; ++ti) {
        bf16x8 qa[NKS];
#pragma unroll
        for (int ks = 0; ks < NKS; ++ks) qa[ks] = *(const LAS bf16x8*)(QS + (ti * 16 + fr) * QLD + ks * 32 + fq * 8);
        float wt[4], rden[4]; int orow[4];
#pragma unroll
        for (int r = 0; r < 4; ++r) { const int t = ti * 16 + 4 * fq + r; wt[r] = __expf(offq + AFT[jq * 64 + t]); orow[r] = rows[t]; }
        { f32x4 aQ = (f32x4){0.f, 0.f, 0.f, 0.f};
#pragma unroll
          for (int ks = 0; ks < NKS; ++ks) { const bf16x8 nb = *(const LAS bf16x8*)(NS + fr * QLD + ks * 32 + fq * 8); aQ = __builtin_amdgcn_mfma_f32_16x16x32_bf16(qa[ks], nb, aQ, 0, 0, 0); }
#pragma unroll
          for (int r = 0; r < 4; ++r) { const float den = accP[ti][2][r] + wt[r] * aQ[r]; const float dd = __shfl(den, F.lane & 48); rden[r] = 1.f / fmaxf(fabsf(dd), 1.f); } }
#pragma unroll
        for (int jt = 0; jt < 2; ++jt) {
            f32x4 aQ = (f32x4){0.f, 0.f, 0.f, 0.f};
#pragma unroll
            for (int ks = 0; ks < NKS; ++ks) aQ = __builtin_amdgcn_mfma_f32_16x16x32_bf16(qa[ks], sb[jt][ks], aQ, 0, 0, 0);
            const int col = h * 256 + (F.wave + 8 * jt) * 16 + fr;
#pragma unroll
            for (int r = 0; r < 4; ++r) OUT[(size_t)orow[r] * 1024 + col] = f2bf((accP[ti][jt][r] + wt[r] * aQ[r]) * rden[r]);
        }
    }
}
DI void ml_phase_k1(Frame& F) {
    bf16_t* ST = WSP(bf16_t, A_ST); float* GAM = WSP(float, A_GAM); const int n = 32 * NSUP * 2;
    const int u0 = (int)((long)n * F.bid / F.G), u1 = (int)((long)n * (F.bid + 1) / F.G);
    MK1Regs R; if (u0 < u1) { mk1_load_gates(F, u0, R); mk1_load_blk(F, u0, 0, R); }
    for (int u = u0; u < u1; ++u) ml_k1(F, ST, GAM, u, R, u + 1 < u1 ? u + 1 : -1);
    __syncthreads();
}
DI void ml_phase_k3(Frame& F) {
    const bf16_t* ST = WSP(bf16_t, A_ST); int u0, u1; unit_range(F, u0, u1);
    for (int u = u0; u < u1; ++u) { const int d = (u / NCHUNK) >> 4; ml_k3(F, ST, WSP(bf16_t, A_HB) + (size_t)d * NT * 1024, u); }
    __syncthreads();
}

DI void phase_finish0(Frame& F) {
    const bf16_t* P = WSP(bf16_t, A_PROJ); const bf16_t* HA = WSP(bf16_t, A_HA); const bf16_t* HB = WSP(bf16_t, A_HB); const bf16_t* XCB = WSP(bf16_t, A_XCB);
    bf16_t* Y = WSP(bf16_t, A_Y);
    const int gw = F.bid * 8 + F.wave, NGW = F.G * 8; const int c0 = F.lane * 16;
    float bn[16], bs[16];
#pragma unroll
    for (int q = 0; q < 16; ++q) { bn[q] = F.in[I0_BNORM][c0 + q]; bs[q] = F.in[I0_BSKIP][c0 + q]; }
    for (int row = gw; row < NT; row += NGW) {
#pragma unroll
        for (int hf = 0; hf < 2; ++hf) {
            const int c = c0 + hf * 8;
            float ga[8], h0[8], h1[8], y[8];
            unpack8(*(const u32x4*)(P + (size_t)row * IN0 + 1024 + c), ga);
            unpack8(*(const u32x4*)(HA + (size_t)row * 1024 + c), h0); unpack8(*(const u32x4*)(HA + ((size_t)NT + row) * 1024 + c), h1);
#pragma unroll
            for (int q = 0; q < 8; ++q) y[q] = gelu_tanh(ga[q]) * (h0[q] + h1[q]);
            *(u32x4*)(Y + (size_t)row * D + c) = pack8(y);
        }
        float hz[16], xc[16]; float ss = 0.f;
#pragma unroll
        for (int hf = 0; hf < 2; ++hf) {
            const int c = c0 + hf * 8;
            float z[8], h0[8], h1[8], x8[8];
            unpack8(*(const u32x4*)(P + (size_t)row * IN0 + 3072 + c), z);
            unpack8(*(const u32x4*)(HB + (size_t)row * 1024 + c), h0); unpack8(*(const u32x4*)(HB + ((size_t)NT + row) * 1024 + c), h1);
            unpack8(*(const u32x4*)(XCB + (size_t)row * 1024 + c), x8);
#pragma unroll
            for (int q = 0; q < 8; ++q) { const float v = sigmoidf_(z[q]) * (h0[q] + h1[q]); hz[hf * 8 + q] = v; xc[hf * 8 + q] = x8[q]; ss += v * v; }
        }
        ss += __shfl_xor(ss, 1); ss += __shfl_xor(ss, 2); ss += __shfl_xor(ss, 4); ss += __shfl_xor(ss, 8);
        const float rs = rsqrtf(ss * (1.f / 256.f) + EPS);
#pragma unroll
        for (int hf = 0; hf < 2; ++hf) {
            float y[8];
#pragma unroll
            for (int q = 0; q < 8; ++q) y[q] = hz[hf * 8 + q] * rs * bn[hf * 8 + q] + bs[hf * 8 + q] * xc[hf * 8 + q];
            *(u32x4*)(Y + (size_t)row * D + 1024 + c0 + hf * 8) = pack8(y);
        }
    }
}

DI void phase_finish1(Frame& F) {
    const bf16_t* P = WSP(bf16_t, A_PROJ); const float* YS = WSP(float, A_YS); const bf16_t* O = WSP(bf16_t, A_O);
    float* YSUM = WSP(float, A_YSUM); bf16_t* GY = WSP(bf16_t, A_GY); bf16_t* Y1 = WSP(bf16_t, A_Y);
    const int gw = F.bid * 8 + F.wave, NGW = F.G * 8;
    const int c8 = F.lane * 8, c16 = F.lane * 16;
    float cd[8], dn[16];
#pragma unroll
    for (int q = 0; q < 8; ++q) cd[q] = F.in[I1_CD][c8 + q];
#pragma unroll
    for (int q = 0; q < 16; ++q) dn[q] = F.in[I1_DNORM][c16 + q];
    for (int row = gw; row < NL; row += NGW) {
        { float u[8]; unpack8(*(const u32x4*)(P + (size_t)row * IN1P + c8), u);
          const f32x4 a0 = *(const f32x4*)(YS + (size_t)row * 512 + c8), a1 = *(const f32x4*)(YS + (size_t)row * 512 + c8 + 4);
          const f32x4 b0 = *(const f32x4*)(YS + ((size_t)NL + row) * 512 + c8), b1 = *(const f32x4*)(YS + ((size_t)NL + row) * 512 + c8 + 4);
          float y[8], gy[8];
#pragma unroll
          for (int q = 0; q < 4; ++q) { y[q] = cd[q] * u[q] + a0[q] + b0[q]; y[4 + q] = cd[4 + q] * u[4 + q] + a1[q] + b1[q]; }
#pragma unroll
          for (int q = 0; q < 8; ++q) gy[q] = gelu_tanh(y[q]);
          *(f32x4*)(YSUM + (size_t)row * 512 + c8) = (f32x4){y[0], y[1], y[2], y[3]}; *(f32x4*)(YSUM + (size_t)row * 512 + c8 + 4) = (f32x4){y[4], y[5], y[6], y[7]};
          *(u32x4*)(GY + (size_t)row * 512 + c8) = pack8(gy); }
        float o[16], gg[16]; float ss = 0.f;
#pragma unroll
        for (int hf = 0; hf < 2; ++hf) {
            float o0[8], o1[8], g8[8];
            unpack8(*(const u32x4*)(O + (size_t)row * 1024 + c16 + hf * 8), o0); unpack8(*(const u32x4*)(O + ((size_t)NL + row) * 1024 + c16 + hf * 8), o1);
            unpack8(*(const u32x4*)(P + (size_t)row * IN1P + 2560 + c16 + hf * 8), g8);
#pragma unroll
            for (int q = 0; q < 8; ++q) { const float v = o0[q] + o1[q]; o[hf * 8 + q] = v; gg[hf * 8 + q] = g8[q]; ss += v * v; }
        }
        ss += __shfl_xor(ss, 1); ss += __shfl_xor(ss, 2); ss += __shfl_xor(ss, 4); ss += __shfl_xor(ss, 8);
        const float rs = rsqrtf(ss * (1.f / 256.f) + EPS);
#pragma unroll
        for (int hf = 0; hf < 2; ++hf) {
            float y[8];
#pragma unroll
            for (int q = 0; q < 8; ++q) y[q] = o[hf * 8 + q] * rs * dn[hf * 8 + q] * siluf_(gg[hf * 8 + q]);
            *(u32x4*)(Y1 + (size_t)row * MIX1 + 512 + c16 + hf * 8) = pack8(y);
        }
    }
}

DI void phase_router(Frame& F) {
    LAS float* rt = (LAS float*)F.lds;
    LAS int* cnt = (LAS int*)(F.lds + 65536);
    const float* modl = WSP(float, WS_MOD) + 5 * 12288;
    {
        f32x4 rw[8];
#pragma unroll
        for (int j = 0; j < 8; ++j) rw[j] = *(const f32x4*)(F.in[I1_ROUTER] + F.tid * 32 + 4 * j);
#pragma unroll
        for (int j = 0; j < 8; ++j)
#pragma unroll
            for (int q = 0; q < 4; ++q) { const int idx = F.tid * 32 + 4 * j + q, k = idx >> 3, e = idx & 7; rt[e * 2048 + k] = rw[j][q]; }
    }
    bf16_t* H = WSP(bf16_t, A_H); int* TOPE = (int*)(F.ws + RT_TOPE); float* TOPW = (float*)(F.ws + RT_TOPW); int* CNT = (int*)(F.ws + RT_CNT);
    for (int blk = F.bid; blk < NL / 128; blk += F.G) {
        if (F.tid < 8) cnt[F.tid] = 0;
        __syncthreads();
        f32x4 gmv[8], shv[8];
        { const int bidx0 = (blk * 128) >> 13;
          const f32x4* gp = (const f32x4*)F.in[I1_N2] + F.lane; const f32x4* scp = (const f32x4*)(modl + bidx0 * 12288 + 8192) + F.lane; const f32x4* shp = (const f32x4*)(modl + bidx0 * 12288 + 6144) + F.lane;
#pragma unroll
          for (int j = 0; j < 8; ++j) { gmv[j] = gp[64 * j] * (scp[64 * j] + 1.f); shv[j] = shp[64 * j]; } }
        f32x4 vn[8];
        { const f32x4* xr0 = (const f32x4*)(F.out + (size_t)(blk * 128 + F.wave * 16) * D) + F.lane;
#pragma unroll
          for (int j = 0; j < 8; ++j) vn[j] = xr0[64 * j]; }
        for (int rr = 0; rr < 16; ++rr) {
            const int row = blk * 128 + F.wave * 16 + rr;
            f32x4 v[8]; float ss = 0.f;
#pragma unroll
            for (int j = 0; j < 8; ++j) { v[j] = vn[j]; ss += (v[j].x * v[j].x + v[j].y * v[j].y) + (v[j].z * v[j].z + v[j].w * v[j].w); }
            if (rr < 15) { const f32x4* xr1 = (const f32x4*)(F.out + (size_t)(row + 1) * D) + F.lane;
#pragma unroll
                for (int j = 0; j < 8; ++j) vn[j] = xr1[64 * j]; }
            const float rstd = rsqrtf(wave_sum(ss) * (1.f / D) + EPS);
            u32x2* o8 = (u32x2*)(H + (size_t)row * D) + F.lane; unsigned* o4 = (unsigned*)((unsigned char*)H + (size_t)row * D) + F.lane;
            float lg[8];
#pragma unroll
            for (int e = 0; e < 8; ++e) lg[e] = 0.f;
#pragma unroll
            for (int j = 0; j < 8; ++j) {
                const f32x4 y = v[j] * rstd * gmv[j] + shv[j];
                if (FP8_MOE) o4[64 * j] = pack4_fp8(y.x * S8_H, y.y * S8_H, y.z * S8_H, y.w * S8_H);
                else { u32x2 w; w.x = cvt_pk_bf16(y.x, y.y); w.y = cvt_pk_bf16(y.z, y.w); o8[64 * j] = w; }
#pragma unroll
                for (int e = 0; e < 8; ++e) { const f32x4 r4 = *(const LAS f32x4*)(rt + e * 2048 + (64 * j + F.lane) * 4); lg[e] += (y.x * r4.x + y.y * r4.y) + (y.z * r4.z + y.w * r4.w); }
            }
#pragma unroll
            for (int e = 0; e < 8; ++e) lg[e] = wave_sum(lg[e]);
            if (F.lane == 0) {
                int e0 = 0; float v0 = lg[0];
#pragma unroll
                for (int e = 1; e < 8; ++e) if (lg[e] > v0) { v0 = lg[e]; e0 = e; }
                int e1 = (e0 + 1) & 7; float v1 = -3.0e38f;
#pragma unroll
                for (int e = 0; e < 8; ++e) if (e != e0 && lg[e] > v1) { v1 = lg[e]; e1 = e; }
                float w1 = 1.f / (1.f + expf(v0 - v1)); if (!(w1 >= 0.f && w1 <= 1.f)) w1 = 0.5f; const float w0 = 1.f - w1;
                TOPE[row * 2] = e0; TOPE[row * 2 + 1] = e1; TOPW[row * 2] = w0; TOPW[row * 2 + 1] = w1;
                atomicAdd((int*)&cnt[e0], 1); atomicAdd((int*)&cnt[e1], 1);
            }
        }
        __syncthreads();
        if (F.tid < 8) CNT[blk * 8 + F.tid] = cnt[F.tid];
        __syncthreads();
    }
}
DI void phase_scatter(Frame& F) {
    LAS int* tot = (LAS int*)F.lds;
    LAS int* pre = tot + 8;
    LAS int* posl = pre + 8;
    const int* CNT = (const int*)(F.ws + RT_CNT); const int* TOPE = (const int*)(F.ws + RT_TOPE); int* POS = (int*)(F.ws + RT_POS);
    int* TEXP = (int*)(F.ws + RT_TEXP); int* NTL = (int*)(F.ws + RT_NTILES);
    const bf16_t* H = WSP(bf16_t, A_H); bf16_t* HS = WSP(bf16_t, A_HS);
    for (int blk = F.bid; blk < NL / 128; blk += F.G) {
        __syncthreads();
        { const int e = F.wave; int t = 0, pr = 0;
          for (int bb = F.lane; bb < 256; bb += 64) { const int c = CNT[bb * 8 + e]; t += c; if (bb < blk) pr += c; }
#pragma unroll
          for (int o = 1; o < 64; o <<= 1) { t += __shfl_xor(t, o); pr += __shfl_xor(pr, o); }
          if (F.lane == 0) { tot[e] = t; pre[e] = pr; } }
        __syncthreads();
        int ebase = 0;
        for (int e = 0; e < F.wave; ++e) ebase += (tot[e] + 255) & ~255;
        { const int e = F.wave; int running = ebase + pre[e];
          for (int q = 0; q < 4; ++q) { const int pi = q * 64 + F.lane; const int row = blk * 128 + (pi >> 1), s = pi & 1;
              const bool match = TOPE[row * 2 + s] == e;
              const unsigned long long bal = __ballot(match);
              const int before = __popcll(bal & ((1ull << F.lane) - 1ull));
              if (match) { posl[pi] = running + before; POS[row * 2 + s] = running + before; }
              running += __popcll(bal); } }
        __syncthreads();
        constexpr int RB = FP8_MOE ? D : 2 * D, NJ = RB / 1024;
        for (int r0 = F.wave * 16; r0 < F.wave * 16 + 16; r0 += 8) {
            u32x4 t[8][NJ]; int pos[8][2];
#pragma unroll
            for (int q = 0; q < 8; ++q) { const int lr = r0 + q; pos[q][0] = posl[2 * lr]; pos[q][1] = posl[2 * lr + 1];
                const u32x4* sp = (const u32x4*)((const unsigned char*)H + (size_t)(blk * 128 + lr) * RB) + F.lane;
#pragma unroll
                for (int j = 0; j < NJ; ++j) t[q][j] = sp[64 * j]; }
#pragma unroll
            for (int q = 0; q < 8; ++q)
#pragma unroll
                for (int sl = 0; sl < 2; ++sl) { u32x4* dd = (u32x4*)((unsigned char*)HS + (size_t)pos[q][sl] * RB) + F.lane;
#pragma unroll
                    for (int j = 0; j < NJ; ++j) dd[64 * j] = t[q][j]; }
        }
        if (blk == 0) {
            int acc = 0, e_of = -1; int ntl = 0;
            for (int e = 0; e < 8; ++e) { const int nt_e = (tot[e] + 255) >> 8; if (e_of < 0 && F.tid >= acc && F.tid < acc + nt_e) e_of = e; acc += nt_e; }
            ntl = acc;
            if (F.tid < 512) TEXP[F.tid] = e_of < 0 ? 0 : e_of;
            if (F.tid == 0) NTL[0] = ntl;
        }
    }
}
DI void phase_final(Frame& F) {
    const bf16_t* YM = WSP(bf16_t, A_YM); const int* POS = (const int*)(F.ws + RT_POS); const float* TOPW = (const float*)(F.ws + RT_TOPW);
    const float* modl = WSP(float, WS_MOD) + 5 * 12288;
    const int gw = F.bid * 8 + F.wave, NGW = F.G * 8;
    for (int run = gw; run < NL / 16; run += NGW) {
      const int bidx = (run * 16) >> 13;
      f32x4 g2v[8], gpv[8];
      { const f32x4* g2 = (const f32x4*)(modl + bidx * 12288 + 10240) + F.lane; const f32x4* gp = (const f32x4*)F.in[I_FNORM] + F.lane;
#pragma unroll
        for (int j = 0; j < 8; ++j) { g2v[j] = g2[64 * j]; gpv[j] = gp[64 * j]; } }
      int pv0 = 0, pv1 = 0; float wv0 = 0.f, wv1 = 0.f;
      if (F.lane < 16) { const int r2 = (run * 16 + F.lane) * 2; pv0 = POS[r2]; pv1 = POS[r2 + 1]; wv0 = TOPW[r2]; wv1 = TOPW[r2 + 1]; }
      for (int rr = 0; rr < 16; ++rr) {
        const int row = run * 16 + rr; const int p0 = __shfl(pv0, rr), p1 = __shfl(pv1, rr); const float w0 = __shfl(wv0, rr), w1 = __shfl(wv1, rr);
        f32x4* xr = (f32x4*)(F.out + (size_t)row * D) + F.lane;
        const u32x2* y0 = (const u32x2*)(YM + (size_t)p0 * D) + F.lane; const u32x2* y1 = (const u32x2*)(YM + (size_t)p1 * D) + F.lane;
        f32x4 v[8]; float ss = 0.f;
#pragma unroll
        for (int j = 0; j < 8; ++j) {
            const u32x2 a = y0[64 * j], b = y1[64 * j];
            f32x4 m; m.x = w0 * bf2f(a.x & 0xffffu) + w1 * bf2f(b.x & 0xffffu); m.y = w0 * bf2f(a.x >> 16) + w1 * bf2f(b.x >> 16);
            m.z = w0 * bf2f(a.y & 0xffffu) + w1 * bf2f(b.y & 0xffffu); m.w = w0 * bf2f(a.y >> 16) + w1 * bf2f(b.y >> 16);
            v[j] = xr[64 * j] + g2v[j] * m;
            ss += (v[j].x * v[j].x + v[j].y * v[j].y) + (v[j].z * v[j].z + v[j].w * v[j].w);
        }
        const float rstd = rsqrtf(wave_sum(ss) * (1.f / D) + EPS);
#pragma unroll
        for (int j = 0; j < 8; ++j) xr[64 * j] = v[j] * rstd * gpv[j];
      }
    }
}

constexpr int NPHASE = 26;
__global__ void __launch_bounds__(512, 2) mega(Params prm) {
    extern __shared__ __attribute__((aligned(16))) unsigned char lds_raw[];
    Frame F;
    F.lds = (LAS unsigned char*)lds_raw;
    F.tid = threadIdx.x; F.lane = F.tid & 63; F.wave = __builtin_amdgcn_readfirstlane(F.tid >> 6);
    F.G = gridDim.x; F.bid = blockIdx.x;
    F.in = prm.in; F.out = prm.out; F.ws = prm.ws;
    volatile LAS unsigned* MISC = (volatile LAS unsigned*)(F.lds + MISC_OFF);
    if (F.tid < 64) MISC[F.tid] = 0u;
    __syncthreads();
    const int lo = prm.lo, hi = prm.hi;
    unsigned* barw = (unsigned*)(F.ws + WS_CTL) + 4096 + prm.li * 4096;
    XcdBarrier bar; bar.bar = barw; bar.x = 0; bar.st = nullptr;
    if (hi - lo > 1) bar = xcd_barrier_post(barw, MISC + 8);
#ifndef PHASE_MASK
#define PHASE_MASK 0xffffffffu
#endif
#define IN(k) (((PHASE_MASK >> (k)) & 1u) && lo <= (k) && (k) < hi)
#define SEAM(k) do { if (IN((k) + 1)) xcd_barrier(bar); asm volatile("" : "+v"(F.tid), "+v"(F.lane)); } while (0)
    LAS unsigned char* ring = F.lds;
    const float* mod0 = WSP(float, WS_MOD); const float* mod1 = WSP(float, WS_MOD) + 5 * 12288;
    float* XCX = WSP(float, WS_XCX);

    if (IN(0)) { phase_prologue(F); SEAM(0); }
    if (IN(1)) { phase_norm(F, F.in[I_X], F.in[I_CTX], F.in[I0_N1], mod0, 0, 2048, WSP(bf16_t, A_H), false, NT); SEAM(1); }
    if (IN(2)) {
        pg8::Gemm g{WSP(bf16_t, A_H), WSP(bf16_t, WT_IN0), D, D, D, 0}; pg8::Sched S = pg8::make_sched(NT / 256, IN0 / 256, F.G, F.bid, D, D);
        pg8::EpiBf16 E{WSP(bf16_t, A_PROJ), IN0, 1.f}; pg8::gemm_phase(ring, g, S, E); tail_convert(F, (NT / 256) * (IN0 / 256), TB_IN0, TQ_IN0); SEAM(2); }
    if (IN(3)) { phase_bias(F); phase_conv(F); SEAM(3); }
    if (IN(4)) {
#ifndef P4_MASK
#define P4_MASK 15
#endif
        if (P4_MASK & 8) { pg8::Gemm g{WSP(bf16_t, A_XCB), WSP(bf16_t, WT_GT), 1024, 1024, 1024, 0}; pg8::Sched S = pg8::make_sched(NT / 256, 1, F.G, F.bid, 1024, 1024);
          pg8::EpiGates E{WSP(float, WS_GATES), F.in[I0_BBIF]}; pg8::gemm_phase(ring, g, S, E); }
        if (P4_MASK & 2) { pg8::Gemm g{WSP(bf16_t, A_XCB), WSP(bf16_t, WT_QK), 1024, 256, 256, 0}; pg8::Sched S = pg8::make_sched(NT / 256, 8, F.G, (F.bid + 96) % F.G, 1024, 256); S.ppb = 2; S.a_blk = 256 * 2;
          pg8::EpiQK E{WSP(bf16_t, A_Q0), WSP(bf16_t, A_K0), 0.0625f}; pg8::gemm_phase(ring, g, S, E); }
        if (P4_MASK & 4) { pg8::Gemm g{WSP(bf16_t, A_PROJ) + 2048, WSP(bf16_t, WT_V), IN0, 256, 256, 0}; pg8::Sched S = pg8::make_sched(NT / 256, 4, F.G, (F.bid + 112) % F.G, IN0, 256); S.ppb = 1; S.a_blk = 256 * 2;
          pg8::EpiBf16 E{WSP(bf16_t, A_V0), 1024, 1.f}; pg8::gemm_phase(ring, g, S, E); }
        if (P4_MASK & 1) { pg8::Gemm g{WSP(bf16_t, A_XCA), WSP(bf16_t, WT_RG), 1024, 128, 128, 0}; pg8::Sched S = pg8::make_sched(NT / 256, 16, F.G, (F.bid + 64) % F.G, 1024, 128); S.ppb = 2; S.a_blk = 128 * 2;
          pg8::EpiRG E{WSP(bf16_t, A_XCA), WSP(bf16_t, A_RG), WSP(bf16_t, A_IX), F.in[I0_ABR], F.in[I0_ABI]}; pg8::gemm_phase(ring, g, S, E); }
        SEAM(4); }
    if (IN(5)) { if (F.bid & 1) { ml_phase_k1(F); rg_pass<1>(F); } else { rg_pass<1>(F); ml_phase_k1(F); } SEAM(5); }
    if (IN(6)) { rg_pass<2>(F); chunk_k2<0, NSUP, 11>(F, WSP(bf16_t, A_ST), WSP(float, A_GAM)); SEAM(6); }
    if (IN(7)) { ml_phase_k3(F); SEAM(7); }
    if (IN(8)) { phase_bias_reduce(F); phase_finish0(F); SEAM(8); }
    if (IN(9)) {
        pg8::Gemm g{WSP(bf16_t, A_Y), WSP(bf16_t, WT_OUT0), D, D, D, 0}; pg8::Sched S = pg8::make_sched(NT / 256, D / 256, F.G, F.bid, D, D);
        pg8::EpiResidT<FP8_FFN ? 1 : 2> E{F.in[I_X], F.in[I_CTX], F.in[I0_N2], F.ws, F.out, 0, 4096, 0, 1.f, 0, 8192, 0};
        pg8::gemm_phase(ring, g, S, E); tail_convert(F, (NT / 256) * (D / 256), TB_OUT0, TQ_OUT0); SEAM(9); }
    if (IN(11)) {
        constexpr int E2 = FP8_FFN ? 2 : 1;
        pg8::Gemm g{WSP(bf16_t, A_H), WSP(bf16_t, WT_FWI0), D / E2, D / E2, D / E2, 0}; pg8::Sched S = pg8::make_sched(NT / 256, FF2 / 256, F.G, F.bid, D / E2, D / E2);
        pg8::EpiSwiglu<FP8_FFN != 0> E{WSP(void, A_ACT0), FF2 / 256, FP8_FFN ? 1.f / (S8_H * S8_W1) : 1.f, WSP(float, WS_SSQ), WSP(float, WS_BIAS2), -1, (LAS float*)(F.lds + pg8::RSTD_OFF)}; pg8::gemm_phase<FP8_FFN != 0>(ring, g, S, E); tail_convert(F, (NT / 256) * (FF2 / 256), TB_FWI, TQ_FWI); SEAM(11); }
    if (IN(12)) {
        constexpr int E2 = FP8_FFN ? 2 : 1;
        pg8::Gemm g{WSP(bf16_t, A_ACT0), WSP(bf16_t, WT_FWO0), FF / E2, FF / E2, FF / E2, 0}; pg8::Sched S = pg8::make_sched(NT / 256, D / 256, F.G, F.bid, FF / E2, FF / E2);
        pg8::EpiResidT<2> E{nullptr, nullptr, F.in[I1_N1], F.ws, F.out, 0, 10240, 0, FP8_FFN ? 1.f / (S8_ACT * S8_W2) : 1.f, 1, 2048, 1};
        pg8::gemm_phase<FP8_FFN != 0>(ring, g, S, E); tail_convert(F, (NT / 256) * (D / 256), TB_FWO, TQ_FWO); SEAM(12); }
    if (IN(14)) {
        pg8::Gemm g{WSP(bf16_t, A_H), WSP(bf16_t, WT_IN1), D, D, D, 0}; pg8::Sched S = pg8::make_sched(NT / 256, IN1P / 256, F.G, F.bid, D, D);
        pg8::EpiBf16N E{WSP(bf16_t, A_PROJ), IN1P, WSP(float, WS_SSQ), WSP(float, WS_BIAS1), IN1P, -1, (LAS float*)(F.lds + pg8::RSTD_OFF)}; pg8::gemm_phase(ring, g, S, E); tail_convert(F, (NT / 256) * (IN1P / 256), TB_IN1, TQ_IN1); SEAM(14); }
    if (IN(15)) {
        { pg8::Gemm g{WSP(bf16_t, A_PROJ), WSP(bf16_t, WT_S5W1), IN1P, 256, 256, 1}; pg8::Sched S = pg8::make_sched(S5ROWS / 256, 96, F.G, F.bid, 16 * IN1P, 256); S.ppb = 3; S.a_blk = 16 * 2;
          pg8::EpiS5A E{WSP(bf16_t, A_YI), WSP(float, A_SLOC)}; pg8::gemm_phase<false, pg8::EpiS5A, pg8::Sched, true, true, 1>(ring, g, S, E); }
        phase_k1<1>(F); SEAM(15); }
    if (IN(16)) { phase_s5_carry(F); chunk_k2<1>(F, WSP(bf16_t, A_ST), WSP(float, A_GAM)); SEAM(16); }
    if (IN(17)) {
        { pg8::Gemm g{WSP(bf16_t, A_SIN), WSP(bf16_t, WT_S5W3), 128, 128, 128, 0}; pg8::Sched S = pg8::make_sched(2048 / 256, 64, F.G, F.bid, 128, 128); S.ppb = 1; S.a_blk = (long)S5ROWS * 128 * 2;
          pg8::EpiS5C E{WSP(bf16_t, A_YI), WSP(float, A_YS)}; pg8::gemm_phase(ring, g, S, E); }
        asm volatile("" : "+v"(F.tid), "+v"(F.lane) :: "memory"); }
    if (IN(17)) { phase_k3<1>(F, WSP(bf16_t, A_O), (size_t)NL * 1024); SEAM(17); }
    if (IN(18)) { phase_finish1(F); SEAM(18); }
    if (IN(19)) {
        pg8::Gemm g{WSP(bf16_t, A_GY), WSP(bf16_t, WT_GLU), 512, 512, 512, 0}; pg8::Sched S = pg8::make_sched(NL / 256, 2, F.G, F.bid, 512, 512);
        pg8::EpiGlu E{WSP(float, A_YSUM), F.in[I1_GLUB], WSP(bf16_t, A_Y)}; pg8::gemm_phase(ring, g, S, E); SEAM(19); }
    if (IN(20)) {
        pg8::Gemm g{WSP(bf16_t, A_Y), WSP(bf16_t, WT_OUT1), MIX1, MIX1, MIX1, 0}; pg8::Sched S = pg8::make_sched(NL / 256, D / 256, F.G, F.bid, MIX1, MIX1);
        pg8::EpiResid E{nullptr, nullptr, nullptr, F.ws, F.out, 1, 4096, 1, 1.f, 0, 0, 0}; pg8::gemm_phase(ring, g, S, E); SEAM(20); }
    if (IN(21)) { phase_router(F); SEAM(21); }
    if (IN(22)) { phase_scatter(F); SEAM(22); }
    if (IN(23)) {
        const int ntl = *(const int*)(F.ws + RT_NTILES); constexpr int E2 = FP8_MOE ? 2 : 1;
        pg8::Gemm g{WSP(bf16_t, A_HS), WSP(bf16_t, WT_MWI), D / E2, D / E2, D / E2, 0}; pg8::Sched S = pg8::make_sched(ntl, FF2 / 256, F.G, F.bid, D / E2, D / E2); S.texp = (const int*)(F.ws + RT_TEXP); S.e_tiles = FF2 / 256;
        pg8::EpiSwiglu<FP8_MOE != 0> E{WSP(void, A_ACT1), FF2 / 256, FP8_MOE ? 1.f / (S8_H * S8_W1) : 1.f}; pg8::gemm_phase<FP8_MOE != 0, decltype(E), pg8::Sched, true, FP8_SP2>(ring, g, S, E); SEAM(23); }
    if (IN(24)) {
        const int ntl = *(const int*)(F.ws + RT_NTILES); constexpr int E2 = FP8_MOE ? 2 : 1;
        pg8::Gemm g{WSP(bf16_t, A_ACT1), WSP(bf16_t, WT_MWO), FF / E2, FF / E2, FF / E2, 0}; pg8::Sched S = pg8::make_sched(ntl, D / 256, F.G, F.bid, FF / E2, FF / E2); S.texp = (const int*)(F.ws + RT_TEXP); S.e_tiles = D / 256;
        pg8::EpiBf16 E{WSP(bf16_t, A_YM), D, FP8_MOE ? 1.f / (S8_ACT * S8_W2) : 1.f}; pg8::gemm_phase<FP8_MOE != 0, decltype(E), pg8::Sched, true, FP8_SP2>(ring, g, S, E); SEAM(24); }
    if (IN(25)) { phase_final(F); }
#undef IN
#undef SEAM
}

extern "C" void kernel_launch(void* const* d_in, const int* in_sizes, int n_in, void* d_out, int out_size, void* d_ws, size_t ws_size, hipStream_t stream) {
    static int grid = 0;
    if (grid == 0) {
        if (n_in != N_IN || out_size != NL * D || ws_size < WS_END) { fprintf(stderr, "kernel_launch: unexpected problem (n_in %d, out %d, ws %zu < %zu)\n", n_in, out_size, ws_size, (size_t)WS_END); grid = -1; return; }
        int dev = 0, cus = 0;
        if (hipGetDevice(&dev) != hipSuccess || hipDeviceGetAttribute(&cus, hipDeviceAttributeMultiprocessorCount, dev) != hipSuccess) { grid = -1; return; }
        if (hipFuncSetAttribute((const void*)mega, hipFuncAttributeMaxDynamicSharedMemorySize, LDS_BYTES) != hipSuccess) { fprintf(stderr, "kernel_launch: hipFuncSetAttribute failed\n"); grid = -1; return; }
        int per_cu = 0; (void)hipOccupancyMaxActiveBlocksPerMultiprocessor(&per_cu, (const void*)mega, 512, LDS_BYTES); (void)hipGetLastError();
        if (per_cu < 1) fprintf(stderr, "kernel_launch: occupancy query reports %d blocks per CU\n", per_cu);
        grid = cus;
    }
    if (grid < 0) return;
    (void)hipMemsetAsync((char*)d_ws + WS_CTL, 0, CTL_BYTES, stream);
    Params p{};
    for (int i = 0; i < N_IN; ++i) p.in[i] = (const float*)d_in[i];
    p.out = (float*)d_out; p.ws = (unsigned char*)d_ws;
#if MK_PER_PHASE
    for (int k = 0; k < NPHASE; ++k) { p.lo = k; p.hi = k + 1; p.li = 0; hipLaunchKernelGGL(mega, dim3(grid), dim3(512), LDS_BYTES, stream, p); }
#elif defined(PROBE_A)
    p.lo = 0; p.hi = PROBE_B; p.li = 0; hipLaunchKernelGGL(mega, dim3(grid), dim3(512), LDS_BYTES, stream, p);
    p.lo = PROBE_A; p.hi = PROBE_B; p.li = 1; hipLaunchKernelGGL(mega, dim3(grid), dim3(512), LDS_BYTES, stream, p);
    if (PROBE_B < NPHASE) { p.lo = PROBE_B; p.hi = NPHASE; p.li = 2; hipLaunchKernelGGL(mega, dim3(grid), dim3(512), LDS_BYTES, stream, p); }
#else
    p.lo = 0; p.hi = NPHASE; p.li = 0; hipLaunchKernelGGL(mega, dim3(grid), dim3(512), LDS_BYTES, stream, p);
#endif
}
```
